# Optimizing an MI355X kernel written in HIP

```python
import jax, jax.numpy as jnp
from jax import lax
import numpy as np

D_MODEL = 2048
BATCH = 4
SEQ = 2048
DEPTH = 1

CHUNK = 64
N_META = 16
D_MIX = D_MODEL
D_POOL = D_MIX // 2
POOL_WINDOWS = (2, 4, 8, 16)
N_POOL_GROUPS = len(POOL_WINDOWS)
POOL_GROUP = D_POOL // N_POOL_GROUPS
D_ATT = D_MIX - D_POOL
HEAD_DIM = 128
N_HEADS = D_ATT // HEAD_DIM
D_IN = D_POOL + 3 * D_ATT + N_HEADS
D_FF = ((8 * D_MODEL // 3 + 255) // 256) * 256
Q_BLOCK = 128
EPS = 1e-6

kernel_name = "hymba_pool_fox_macaron_block"


def rmsnorm(x, g):
    xf = x.astype(jnp.float32)
    y = xf * lax.rsqrt(jnp.mean(xf * xf, axis=-1, keepdims=True) + EPS)
    return (y * g.astype(jnp.float32)).astype(x.dtype)


def swiglu(x, w_gate, w_up, w_down):
    return (jax.nn.silu(x @ w_gate) * (x @ w_up)) @ w_down


def pool_mixer(p, pool_w, pool_scale):
    B, L, _ = p.shape
    pg = p.reshape(B, L, N_POOL_GROUPS, POOL_GROUP)
    c = jnp.cumsum(pg.astype(jnp.float32), axis=1)
    c = jnp.pad(c, ((0, 0), (1, 0), (0, 0), (0, 0)))
    win = jnp.array(POOL_WINDOWS, dtype=jnp.int32)
    end = jnp.arange(1, L + 1, dtype=jnp.int32)[:, None]
    start = jnp.maximum(end - win[None, :], 0)
    gidx = jnp.arange(N_POOL_GROUPS, dtype=jnp.int32)[None, :]
    window_sum = c[:, end, gidx] - c[:, start, gidx]
    count = (end - start).astype(jnp.float32)[None, :, :, None]
    pooled = (window_sum / count - pg.astype(jnp.float32)).astype(p.dtype)
    mixed = jnp.einsum('blgc,gcd->blgd', pooled, pool_w)
    return mixed.reshape(B, L, D_POOL) * pool_scale


def fox_attention(q, k, v, log_f):
    B, L, H, Dh = q.shape
    scale = 1.0 / np.sqrt(Dh).astype(np.float32)
    cum = jnp.cumsum(log_f, axis=-1)
    n_blocks = -(-L // Q_BLOCK)
    Lp = n_blocks * Q_BLOCK
    qp = jnp.pad(q, ((0, 0), (0, Lp - L), (0, 0), (0, 0)))
    cqp = jnp.pad(cum, ((0, 0), (0, 0), (0, Lp - L)))
    qb = qp.reshape(B, n_blocks, Q_BLOCK, H, Dh).transpose(1, 0, 2, 3, 4)
    cqb = cqp.reshape(B, H, n_blocks, Q_BLOCK).transpose(2, 0, 1, 3)
    kpos = jnp.arange(L, dtype=jnp.int32)

    def one_block(args):
        qi, cqi, bi = args
        qpos = bi * Q_BLOCK + jnp.arange(Q_BLOCK, dtype=jnp.int32)
        s = jnp.einsum('bqhd,bkhd->bhqk', qi, k).astype(jnp.float32) * scale
        s = s + (cqi[:, :, :, None] - cum[:, :, None, :])
        s = jnp.where(qpos[:, None] >= kpos[None, :], s, -jnp.inf)
        pr = jax.nn.softmax(s, axis=-1)
        return jnp.einsum('bhqk,bkhd->bqhd', pr.astype(v.dtype), v)

    out = lax.map(one_block, (qb, cqb, jnp.arange(n_blocks, dtype=jnp.int32)))
    out = out.transpose(1, 0, 2, 3, 4).reshape(B, Lp, H * Dh)
    return out[:, :L]


def setup_inputs(seed: int = 0) -> dict:
    key = jax.random.key(seed)
    ks = jax.random.split(key, 20)
    f32 = jnp.float32

    def nrm(k, shape, s):
        return jax.random.normal(k, shape, f32) * s

    def gain(k, shape):
        return 1.0 + 0.05 * jax.random.normal(k, shape, f32)

    return {
        "x": jax.random.normal(ks[0], (BATCH, SEQ, D_MODEL), f32),
        "meta_tokens": nrm(ks[1], (N_META, D_MODEL), 1.0),
        "ffn1_norm": gain(ks[2], (DEPTH, D_MODEL)),
        "ffn1_w_gate": nrm(ks[3], (DEPTH, D_MODEL, D_FF), D_MODEL ** -0.5),
        "ffn1_w_up": nrm(ks[4], (DEPTH, D_MODEL, D_FF), D_MODEL ** -0.5),
        "ffn1_w_down": nrm(ks[5], (DEPTH, D_FF, D_MODEL), D_FF ** -0.5),
        "mix_norm": gain(ks[6], (DEPTH, D_MODEL)),
        "w_in": nrm(ks[7], (DEPTH, D_MODEL, D_IN), D_MODEL ** -0.5),
        "b_forget": jax.random.uniform(ks[8], (DEPTH, N_HEADS), f32, minval=1.0, maxval=5.0),
        "q_norm": gain(ks[9], (DEPTH, HEAD_DIM)),
        "k_norm": gain(ks[10], (DEPTH, HEAD_DIM)),
        "pool_w": nrm(ks[11], (DEPTH, N_POOL_GROUPS, POOL_GROUP, POOL_GROUP), POOL_GROUP ** -0.5),
        "pool_scale": 1.0 + 0.1 * jax.random.normal(ks[12], (DEPTH, D_POOL), f32),
        "w_out": nrm(ks[13], (DEPTH, D_MIX, D_MODEL), D_MIX ** -0.5),
        "ffn2_norm": gain(ks[14], (DEPTH, D_MODEL)),
        "ffn2_w_gate": nrm(ks[15], (DEPTH, D_MODEL, D_FF), D_MODEL ** -0.5),
        "ffn2_w_up": nrm(ks[16], (DEPTH, D_MODEL, D_FF), D_MODEL ** -0.5),
        "ffn2_w_down": nrm(ks[17], (DEPTH, D_FF, D_MODEL), D_FF ** -0.5),
    }


def reference(x, meta_tokens, ffn1_norm, ffn1_w_gate, ffn1_w_up, ffn1_w_down, mix_norm, w_in,
              b_forget, q_norm, k_norm, pool_w, pool_scale, w_out, ffn2_norm, ffn2_w_gate,
              ffn2_w_up, ffn2_w_down):
    B = x.shape[0]
    meta = jnp.broadcast_to(meta_tokens[None].astype(x.dtype), (B, N_META, D_MODEL))
    h = jnp.concatenate([meta, x], axis=1)
    L = h.shape[1]
    for i in range(DEPTH):
        h = h + 0.5 * swiglu(rmsnorm(h, ffn1_norm[i]), ffn1_w_gate[i], ffn1_w_up[i], ffn1_w_down[i])

        u = rmsnorm(h, mix_norm[i])
        z = u @ w_in[i]
        o = D_POOL
        p = z[..., :o]
        q = z[..., o:o + D_ATT].reshape(B, L, N_HEADS, HEAD_DIM)
        k = z[..., o + D_ATT:o + 2 * D_ATT].reshape(B, L, N_HEADS, HEAD_DIM)
        v = z[..., o + 2 * D_ATT:o + 3 * D_ATT].reshape(B, L, N_HEADS, HEAD_DIM)
        f_logit = z[..., o + 3 * D_ATT:]

        pool_out = pool_mixer(p, pool_w[i], pool_scale[i])

        q = rmsnorm(q, q_norm[i])
        k = rmsnorm(k, k_norm[i])
        log_f = jax.nn.log_sigmoid(f_logit.astype(jnp.float32) + b_forget[i].astype(jnp.float32))
        att_out = fox_attention(q, k, v, log_f.transpose(0, 2, 1))

        mix = jnp.concatenate([pool_out, att_out.astype(pool_out.dtype)], axis=-1)
        h = h + mix @ w_out[i]

        h = h + 0.5 * swiglu(rmsnorm(h, ffn2_norm[i]), ffn2_w_gate[i], ffn2_w_up[i], ffn2_w_down[i])
    return h[:, N_META:]
```

```cpp
#include <hip/hip_runtime.h>
#include <hip/hip_cooperative_groups.h>
#include <cstdio>
namespace cg = cooperative_groups;

#define LAS __attribute__((address_space(3)))
typedef unsigned short bf16_t;
typedef short bf16x8 __attribute__((ext_vector_type(8)));
typedef float f32x4 __attribute__((ext_vector_type(4)));
typedef unsigned u32x4 __attribute__((ext_vector_type(4)));
typedef unsigned u32x2 __attribute__((ext_vector_type(2)));
typedef short s16x4 __attribute__((ext_vector_type(4)));

constexpr int D = 2048, NB = 4, SEQ = 2048, NMETA = 16, L = NMETA + SEQ  , MX = NB * SEQ  , M = MX + NMETA  , MP = 8448;
constexpr int DFF = 5632, DIN = 4104, NH = 8, DHD = 128, ZW = 4096  , CUML = 2112;
constexpr float EPS = 1e-6f;

constexpr size_t al256(size_t x) { return (x + 255) & ~(size_t)255; }
constexpr size_t WS_GU1 = 0;
constexpr size_t WS_D1 = WS_GU1 + (size_t)2 * DFF * D * 2;
constexpr size_t WS_IN = WS_D1 + (size_t)D * DFF * 2;
constexpr size_t WS_OUT = WS_IN + (size_t)4352 * D * 2;
constexpr size_t WS_POOL = WS_OUT + (size_t)D * D * 2;
constexpr size_t WS_GU2 = WS_POOL + (size_t)1024 * 256 * 2;
constexpr size_t WS_D2 = WS_GU2 + (size_t)2 * DFF * D * 2;
constexpr size_t WS_HB = WS_D2 + (size_t)D * DFF * 2;
constexpr size_t WS_ACT = WS_HB + (size_t)MP * D * 2;
constexpr size_t WS_Z = WS_ACT;
constexpr size_t WS_POOLED = WS_Z + (size_t)MP * ZW * 2;
constexpr size_t WS_MIX = WS_ACT + (size_t)MP * DFF * 2;
constexpr size_t WS_HMETA = WS_MIX + (size_t)MP * D * 2;
constexpr size_t WS_FLOG = WS_HMETA + (size_t)NMETA * D * 4;
constexpr size_t WS_CUM = WS_FLOG + (size_t)MP * 8 * 4;
constexpr size_t WS_SSQ0 = WS_CUM + (size_t)32 * CUML * 4;
constexpr size_t WS_SSQ1 = WS_SSQ0 + (size_t)MP * 4;
constexpr size_t WS_SSQ2 = WS_SSQ1 + (size_t)MP * 4;
constexpr size_t WS_SSQQK = WS_SSQ2 + (size_t)MP * 4;
constexpr size_t WS_CTR = WS_SSQQK + (size_t)MP * 64 * 4;
constexpr size_t WS_BAR = WS_CTR + 256;
constexpr size_t WS_END = WS_BAR + 3456 * 4;
static_assert(WS_POOLED + (size_t)MP * 1024 * 2 <= WS_MIX, "z + pooled must fit in the act region");

struct Params { const float* in[18]; float* out; unsigned char* ws; };

__device__ __forceinline__ unsigned cvt_pk_bf16(float lo, float hi) { unsigned r; asm volatile("v_cvt_pk_bf16_f32 %0, %1, %2" : "=v"(r) : "v"(lo), "v"(hi)); return r; }
#define LDS_BARRIER() do { asm volatile("s_waitcnt lgkmcnt(0)" ::: "memory"); __builtin_amdgcn_s_barrier(); asm volatile("" ::: "memory"); } while (0)
__device__ __forceinline__ int phase_tid(int wave_s) { int lane; asm volatile("v_mbcnt_lo_u32_b32 %0, -1, 0\n\tv_mbcnt_hi_u32_b32 %0, -1, %0" : "=v"(lane)); return wave_s * 64 + lane; }
__device__ __forceinline__ float bf_lo(unsigned u) { return __uint_as_float(u << 16); }
__device__ __forceinline__ float bf_hi(unsigned u) { return __uint_as_float(u & 0xffff0000u); }
__device__ __forceinline__ int grow_of(int b, int pos) { return pos < NMETA ? MX + pos : b * SEQ + pos - NMETA; }
__device__ __forceinline__ float xsum16_32(float v) { v += __shfl_xor(v, 16); v += __shfl_xor(v, 32); return v; }


#define XB_TMO      128
#define XB_XCNT(j)  (256  + 64 * (j))
#define XB_XSUB(j)  (1280 + 64 * (j))
#define XB_XGEN(j)  (2304 + 64 * (j))
#define XB_TOP      3328
#define XB_TOPGEN   3392
#define XCD_BAR_WORDS 3456
#define XB_SPIN_CAP (1u << 18)
__device__ __forceinline__ unsigned xb_ld(unsigned* p)              { return __hip_atomic_load(p, __ATOMIC_RELAXED, __HIP_MEMORY_SCOPE_AGENT); }
__device__ __forceinline__ unsigned xb_add(unsigned* p, unsigned v) { return __hip_atomic_fetch_add(p, v, __ATOMIC_RELAXED, __HIP_MEMORY_SCOPE_AGENT); }
__device__ __forceinline__ unsigned xb_xcc_id() { return (unsigned)__builtin_amdgcn_s_getreg((3 << 11) | 20) & 0xFu; }
#define XB_SPIN(cond, bar) do { unsigned _sp = 0; while (cond) { __builtin_amdgcn_s_sleep(1); \
    if ((++_sp & 255u) == 0u) { if (xb_ld(&(bar)[XB_TMO])) break; if (_sp > XB_SPIN_CAP) { atomicAdd(&(bar)[XB_TMO], 1u); break; } } } } while (0)
struct XcdBarrier { unsigned* bar; unsigned x; volatile LAS unsigned* st; };
__device__ __forceinline__ XcdBarrier xcd_barrier_post(unsigned* bar, volatile LAS unsigned* st, const int wave_s) {
    XcdBarrier b; b.bar = bar; b.x = xb_xcc_id(); b.st = st;
    if (phase_tid(wave_s) == 0) (void)xb_add(&bar[XB_XCNT(b.x)], 1u);
    return b;
}
__device__ __forceinline__ void xcd_barrier_complete(unsigned* bar, unsigned x, unsigned& nloc, unsigned& nx) {
    const unsigned G = gridDim.x * gridDim.y * gridDim.z;
    unsigned sum, cnt, mine, sp = 0u;
    for (;;) {
        sum = 0u; cnt = 0u; mine = 0u;
#pragma unroll
        for (unsigned j = 0; j < 16; ++j) { const unsigned c = xb_ld(&bar[XB_XCNT(j)]); sum += c; cnt += (c > 0u) ? 1u : 0u; mine = (j == x) ? c : mine; }
        if (sum == G) break;
        __builtin_amdgcn_s_sleep(1);
        if ((++sp & 255u) == 0u) { if (xb_ld(&bar[XB_TMO])) break; if (sp > XB_SPIN_CAP) { atomicAdd(&bar[XB_TMO], 1u); break; } }
    }
    nloc = mine > 0u ? mine : 1u; nx = cnt > 0u ? cnt : 1u;
}
__device__ __forceinline__ void xcd_barrier(const XcdBarrier& b, const int wave_s) {
    asm volatile("s_waitcnt vmcnt(0)" ::: "memory");
    __syncthreads();
    if (phase_tid(wave_s) == 0) {
        unsigned* bar = b.bar;
        __builtin_amdgcn_s_waitcnt(0);
        unsigned nloc = b.st[0], nx = b.st[1];
        if (nloc == 0u) { xcd_barrier_complete(bar, b.x, nloc, nx); b.st[0] = nloc; b.st[1] = nx; }
        const unsigned old = xb_add(&bar[XB_XSUB(b.x)], 1u);
        const unsigned gen = old / nloc;
        if (old + 1u == (gen + 1u) * nloc) {
            __builtin_amdgcn_fence(__ATOMIC_RELEASE, "agent");
            asm volatile("s_waitcnt vmcnt(0)" ::: "memory");
            const unsigned og = xb_add(&bar[XB_TOP], 1u);
            const unsigned tg = og / nx;
            if (og + 1u == (tg + 1u) * nx) xb_add(&bar[XB_TOPGEN], 1u);
            else XB_SPIN(xb_ld(&bar[XB_TOPGEN]) == tg, bar);
            __builtin_amdgcn_fence(__ATOMIC_ACQUIRE, "agent");
            xb_add(&bar[XB_XGEN(b.x)], 1u);
            asm volatile("s_waitcnt vmcnt(0)" ::: "memory");
        } else {
            XB_SPIN(xb_ld(&bar[XB_XGEN(b.x)]) == gen, bar);
            __builtin_amdgcn_fence(__ATOMIC_ACQUIRE, "agent");
            asm volatile("s_waitcnt vmcnt(0)" ::: "memory");
        }
    }
    __syncthreads();
}

constexpr int BM = 256, BK = 64, HALF = 128, HTB = HALF * BK * 2, STAGE_BYTES = 8 * HTB, NXCD = 8, WGM = 4;
__device__ __forceinline__ int lds_byte(int r, int c) { const int st = (r >> 4) * 2 + (c >> 5), rr = r & 15, cc = c & 31, ob = rr * 64 + cc * 2; return st * 1024 + (ob ^ (((ob >> 9) & 1) << 5)); }
__device__ __forceinline__ void stage_rc(int b, int& R, int& C) { const int st = b / 1024, sb = b % 1024, swz = sb ^ (((sb >> 9) & 1) << 5); R = (st >> 1) * 16 + swz / 64; C = (st & 1) * 32 + (swz % 64) / 2; }
__device__ __forceinline__ int perm32(int rho) { const int n = rho >> 4, i = rho & 15; return 8 * (i >> 2) + 4 * n + (i & 3); }

struct Unit { int pm, pn; };
struct Gemm { const bf16_t* A; const bf16_t* Bt; int lda, ldb, K, a_pn_off; };

struct StaticOrder {
    int nM, nN, nwg, G, c;
    __device__ __forceinline__ void init(int nM_, int nN_, int G_, int c_) { nM = nM_; nN = nN_; nwg = nM * nN; G = G_; c = c_; }
    __device__ __forceinline__ bool next(int i, Unit& u) const {
        const long Lx = (long)i * G + c; if (Lx >= nwg) return false;
        int wgid = (int)Lx; { const int q = nwg / NXCD, r = nwg % NXCD, xcd = wgid % NXCD, off = wgid / NXCD; wgid = (xcd < r ? xcd * (q + 1) : r * (q + 1) + (xcd - r) * q) + off; }
        const int nig = WGM * nN, gid = wgid / nig, fm = gid * WGM, gsz = (nM - fm) < WGM ? (nM - fm) : WGM;
        u.pm = fm + ((wgid % nig) % gsz); u.pn = (wgid % nig) / gsz; return true;
    }
};

template <class Epi>
__device__ __forceinline__ void gemm_phase(LAS unsigned char* lds, const Gemm g, const StaticOrder& S, const Epi& E, const int wave_s) {
    int tid_ = phase_tid(wave_s);
    const int tid = tid_, wid = __builtin_amdgcn_readfirstlane(tid >> 6), lane = tid & 63, wr = wid >> 2, wc = wid & 3, fr = lane & 15, fq = lane >> 4;
    const int K = g.K, nt = K / BK;
    unsigned voffA[2], voffB[2];
#pragma unroll
    for (int i = 0; i < 2; ++i) { int R, C; stage_rc(tid * 16 + i * 8192, R, C); const int Rb = (R & ~31) + perm32(R & 31);
        voffA[i] = (unsigned)(R * g.lda + C) * 2u; voffB[i] = (unsigned)(Rb * g.ldb + C) * 2u; }
    const size_t kstep = (size_t)(BK * 2);
    const size_t hstepA = (size_t)HALF * g.lda * 2, hstepB = (size_t)HALF * g.ldb * 2;
    const size_t tstepA = 2 * hstepA, tstepB = 2 * hstepB;
    const unsigned ldsw = (unsigned)wid * 1024u;
    const int aoff = lds_byte(wr * 64 + fr, fq * 8), boff = lds_byte(wc * 32 + fr, fq * 8);
#define PG8_SA(b, h) (((b) * 2 + (h)) * HTB)
#define PG8_SB(b, h) ((4 + (b) * 2 + (h)) * HTB)
#define PG8_STAGE(bufoff, gbase, voff) do { _Pragma("unroll") for (int _i = 0; _i < 2; ++_i) \
        __builtin_amdgcn_global_load_lds((const unsigned*)((const char*)(gbase) + (voff)[_i]), (LAS unsigned*)(lds + (bufoff) + ldsw + _i * 8192), 16, 0, 0); } while (0)
#define PG8_LDA(dst, b, h) do { _Pragma("unroll") for (int m = 0; m < 4; ++m) _Pragma("unroll") for (int k = 0; k < 2; ++k) dst[m][k] = *(const LAS bf16x8*)(lds + PG8_SA(b, h) + aoff + m * 2048 + k * 1024); } while (0)
#define PG8_LDB(dst, b, h) do { _Pragma("unroll") for (int n = 0; n < 2; ++n) _Pragma("unroll") for (int k = 0; k < 2; ++k) dst[n][k] = *(const LAS bf16x8*)(lds + PG8_SB(b, h) + boff + n * 2048 + k * 1024); } while (0)
#define PG8_MMA(ai, bj, At, Bt) do { __builtin_amdgcn_s_setprio(1); _Pragma("unroll") for (int m = 0; m < 4; ++m) _Pragma("unroll") for (int n = 0; n < 2; ++n) _Pragma("unroll") for (int k = 0; k < 2; ++k) \
        acc[ai][bj][m][n] = __builtin_amdgcn_mfma_f32_16x16x32_bf16(Bt[n][k], At[m][k], acc[ai][bj][m][n], 0, 0, 0); __builtin_amdgcn_s_setprio(0); } while (0)
#define PG8_WAIT_V(n) asm volatile("s_waitcnt vmcnt(" #n ")" ::: "memory")
#define PG8_WAIT_L(n) asm volatile("s_waitcnt lgkmcnt(" #n ")" ::: "memory")
#define PG8_BAR __builtin_amdgcn_s_barrier()
#define PG8_SCHED __builtin_amdgcn_sched_barrier(0)
    Unit cur, nxt; int ui = 0;
    if (!S.next(0, cur)) return;
    f32x4 acc[2][2][4][2];
#pragma unroll
    for (int a = 0; a < 2; ++a)
#pragma unroll
        for (int b = 0; b < 2; ++b)
#pragma unroll
            for (int m = 0; m < 4; ++m)
#pragma unroll
                for (int n = 0; n < 2; ++n) acc[a][b][m][n] = (f32x4){0.f, 0.f, 0.f, 0.f};
    bf16x8 At[4][2], B0[2][2], B1[2][2];
    float rsv[8];
#pragma unroll
    for (int i = 0; i < 8; ++i) rsv[i] = 0.f;
    const char* cA = (const char*)g.A + (size_t)cur.pm * tstepA + (size_t)cur.pn * g.a_pn_off; const char* cB = (const char*)g.Bt + (size_t)cur.pn * tstepB;
    PG8_STAGE(PG8_SB(0, 0), cB, voffB); PG8_STAGE(PG8_SA(0, 0), cA, voffA); PG8_STAGE(PG8_SB(0, 1), cB + hstepB, voffB); PG8_STAGE(PG8_SA(0, 1), cA + hstepA, voffA);
    if (wr == 1) PG8_BAR;
    PG8_WAIT_V(4); PG8_BAR;
    PG8_STAGE(PG8_SB(1, 0), cB + kstep, voffB); PG8_STAGE(PG8_SA(1, 0), cA + kstep, voffA); PG8_STAGE(PG8_SB(1, 1), cB + hstepB + kstep, voffB);
    PG8_WAIT_V(6); PG8_BAR;
    for (;;) {
        const bool has_next = S.next(ui + 1, nxt);
        const char* nA = has_next ? (const char*)g.A + (size_t)nxt.pm * tstepA + (size_t)nxt.pn * g.a_pn_off : cA; const char* nB = has_next ? (const char*)g.Bt + (size_t)nxt.pn * tstepB : cB;
        for (int t = 0; t < nt; t += 2) {
            const bool last = (t == nt - 2);
            const char* a1 = cA + (size_t)(t + 1) * kstep;
            const char* a2 = last ? nA : cA + (size_t)(t + 2) * kstep; const char* b2 = last ? nB : cB + (size_t)(t + 2) * kstep;
            const char* a3 = a2 + kstep; const char* b3 = b2 + kstep;
            if (last) E.prefetch(cur, wr, fr, rsv);
            PG8_LDB(B0, 0, 0); PG8_SCHED; PG8_LDA(At, 0, 0); PG8_STAGE(PG8_SA(1, 1), a1 + hstepA, voffA);
            PG8_WAIT_L(8); PG8_BAR; PG8_WAIT_L(0); PG8_MMA(0, 0, At, B0); PG8_BAR; PG8_SCHED;
            PG8_LDB(B1, 0, 1); PG8_STAGE(PG8_SB(0, 0), b2, voffB);
            PG8_BAR; PG8_WAIT_L(0); PG8_MMA(0, 1, At, B1); PG8_BAR;
            PG8_LDA(At, 0, 1); PG8_STAGE(PG8_SA(0, 0), a2, voffA);
            PG8_BAR; PG8_WAIT_L(0); PG8_MMA(1, 0, At, B0); PG8_BAR; PG8_SCHED;
            PG8_STAGE(PG8_SB(0, 1), b2 + hstepB, voffB);
            PG8_WAIT_V(6); PG8_BAR; PG8_MMA(1, 1, At, B1); PG8_BAR;
            PG8_LDB(B0, 1, 0); PG8_SCHED; PG8_LDA(At, 1, 0); PG8_STAGE(PG8_SA(0, 1), a2 + hstepA, voffA);
            PG8_WAIT_L(8); PG8_BAR; PG8_WAIT_L(0); PG8_MMA(0, 0, At, B0); PG8_BAR; PG8_SCHED;
            PG8_LDB(B1, 1, 1); PG8_STAGE(PG8_SB(1, 0), b3, voffB);
            PG8_BAR; PG8_WAIT_L(0); PG8_MMA(0, 1, At, B1); PG8_BAR;
            PG8_LDA(At, 1, 1); PG8_STAGE(PG8_SA(1, 0), a3, voffA);
            PG8_BAR; PG8_WAIT_L(0); PG8_MMA(1, 0, At, B0); PG8_BAR; PG8_SCHED;
            PG8_STAGE(PG8_SB(1, 1), b3 + hstepB, voffB);
            PG8_WAIT_V(6); PG8_BAR; PG8_MMA(1, 1, At, B1); PG8_BAR;
        }
        E(acc, cur, wr, wc, fr, fq, rsv);
        if (!has_next) break;
#pragma unroll
        for (int a = 0; a < 2; ++a)
#pragma unroll
            for (int b = 0; b < 2; ++b)
#pragma unroll
                for (int m = 0; m < 4; ++m)
#pragma unroll
                    for (int n = 0; n < 2; ++n) acc[a][b][m][n] = (f32x4){0.f, 0.f, 0.f, 0.f};
        cur = nxt; cA = nA; cB = nB; ++ui;
    }
    PG8_WAIT_V(0);
    if (wr == 0) PG8_BAR;
    PG8_BAR;
#undef PG8_SA
#undef PG8_SB
#undef PG8_STAGE
#undef PG8_LDA
#undef PG8_LDB
#undef PG8_MMA
#undef PG8_WAIT_V
#undef PG8_WAIT_L
#undef PG8_BAR
#undef PG8_SCHED
}

__device__ __forceinline__ float silu_mul(float g, float u) { return g * __builtin_amdgcn_rcpf(1.0f + __expf(-g)) * u; }

struct EpiSwiGLU {
    const float* ssq; bf16_t* act;
    __device__ __forceinline__ void prefetch(const Unit& u, int wr, int fr, float (&rsv)[8]) const {
#pragma unroll
        for (int ai = 0; ai < 2; ++ai)
#pragma unroll
            for (int m = 0; m < 4; ++m) rsv[ai * 4 + m] = ssq[u.pm * BM + wr * 64 + fr + ai * HALF + m * 16]; }
    __device__ __forceinline__ void operator()(const f32x4 (&acc)[2][2][4][2], const Unit& u, int wr, int wc, int fr, int fq, const float (&rsv)[8]) const {
        const int row0 = u.pm * BM + wr * 64 + fr, col0 = u.pn * 128 + wc * 32 + 8 * fq;
#pragma unroll
        for (int ai = 0; ai < 2; ++ai)
#pragma unroll
            for (int m = 0; m < 4; ++m) {
                const int row = row0 + ai * HALF + m * 16;
                {
                    const float rs = __builtin_amdgcn_rsqf(rsv[ai * 4 + m] * (1.0f / D) + EPS), c1 = rs * -1.4426950408889634f, r2 = rs * rs;
                    u32x4 o;
#pragma unroll
                    for (int n = 0; n < 2; ++n) {
                        const f32x4 ga = acc[ai][0][m][n], ua = acc[ai][1][m][n];
                        const f32x4 t = ga * c1;
                        f32x4 d = {__builtin_amdgcn_exp2f(t[0]), __builtin_amdgcn_exp2f(t[1]), __builtin_amdgcn_exp2f(t[2]), __builtin_amdgcn_exp2f(t[3])};
                        d = d + 1.0f;
                        f32x4 r = {__builtin_amdgcn_rcpf(d[0]), __builtin_amdgcn_rcpf(d[1]), __builtin_amdgcn_rcpf(d[2]), __builtin_amdgcn_rcpf(d[3])};
                        const f32x4 v = (ga * ua) * (r * r2);
                        o[2 * n] = cvt_pk_bf16(v[0], v[1]); o[2 * n + 1] = cvt_pk_bf16(v[2], v[3]);
                    }
                    *(u32x4*)(act + (size_t)row * DFF + col0) = o;
                }
            }
    }
};

template <int MODE> struct EpiRes {
    const float* x; const float* meta; float* out; float* hmeta; bf16_t* hb; float* ssq;
    __device__ __forceinline__ void prefetch(const Unit&, int, int, float (&)[8]) const {}
    __device__ __forceinline__ void operator()(const f32x4 (&acc)[2][2][4][2], const Unit& u, int wr, int wc, int fr, int fq, const float (&rsv)[8]) const {
        const int row0 = u.pm * BM + wr * 64 + fr, col0 = u.pn * BM + wc * 32 + 8 * fq;
        const float fac = (MODE == 6) ? 1.0f : 0.5f;
#pragma unroll
        for (int ai = 0; ai < 2; ++ai) {
            f32x4 r[(MODE == 2) ? 4 : 1][2][2]; u32x4 hr[(MODE == 2) ? 1 : 4][2];
#pragma unroll
            for (int m = 0; m < 4; ++m)
#pragma unroll
                for (int bj = 0; bj < 2; ++bj) { const size_t off = (size_t)(row0 + ai * HALF + m * 16) * D + col0 + bj * HALF;
                    if (MODE == 2) { r[m][bj][0] = *(const f32x4*)(x + off); r[m][bj][1] = *(const f32x4*)(x + off + 4); }
                    else hr[m][bj] = *(const u32x4*)(hb + off); }
#pragma unroll
            for (int m = 0; m < 4; ++m) {
                const int row = row0 + ai * HALF + m * 16;
                float ss = 0.f;
#pragma unroll
                for (int bj = 0; bj < 2; ++bj) {
                    const int c = col0 + bj * HALF;
                    f32x4 r0, r1;
                    if (MODE == 2) { r0 = r[m][bj][0]; r1 = r[m][bj][1]; }
                    else { const u32x4 h = hr[m][bj]; r0 = (f32x4){bf_lo(h[0]), bf_hi(h[0]), bf_lo(h[1]), bf_hi(h[1])}; r1 = (f32x4){bf_lo(h[2]), bf_hi(h[2]), bf_lo(h[3]), bf_hi(h[3])}; }
                    const f32x4 v0 = r0 + acc[ai][bj][m][0] * fac, v1 = r1 + acc[ai][bj][m][1] * fac;
                    if (MODE == 8) { float* orow = out + (size_t)row * D; *(f32x4*)(orow + c) = v0; *(f32x4*)(orow + c + 4) = v1; }
                    else {
                        u32x4 o; o[0] = cvt_pk_bf16(v0[0], v0[1]); o[1] = cvt_pk_bf16(v0[2], v0[3]); o[2] = cvt_pk_bf16(v1[0], v1[1]); o[3] = cvt_pk_bf16(v1[2], v1[3]);
                        *(u32x4*)(hb + (size_t)row * D + c) = o;
                        ss += v0[0] * v0[0] + v0[1] * v0[1] + v0[2] * v0[2] + v0[3] * v0[3] + v1[0] * v1[0] + v1[1] * v1[1] + v1[2] * v1[2] + v1[3] * v1[3];
                    }
                }
                if (MODE != 8) { ss = xsum16_32(ss); if (fq == 0) atomicAdd(ssq + row, ss); }
            }
        }
    }
};

struct EpiZ {
    const float* ssq; bf16_t* z; float* flog; float* ssqqk;
    __device__ __forceinline__ void prefetch(const Unit& u, int wr, int fr, float (&rsv)[8]) const {
#pragma unroll
        for (int ai = 0; ai < 2; ++ai)
#pragma unroll
            for (int m = 0; m < 4; ++m) rsv[ai * 4 + m] = ssq[u.pm * BM + wr * 64 + fr + ai * HALF + m * 16]; }
    __device__ __forceinline__ void operator()(const f32x4 (&acc)[2][2][4][2], const Unit& u, int wr, int wc, int fr, int fq, const float (&rsv)[8]) const {
        const int row0 = u.pm * BM + wr * 64 + fr, col0 = u.pn * BM + wc * 32 + 8 * fq, pn = u.pn;
#pragma unroll
        for (int ai = 0; ai < 2; ++ai)
#pragma unroll
            for (int m = 0; m < 4; ++m) {
                const int row = row0 + ai * HALF + m * 16;
                const bool ok = row < M;
                const float rs = __builtin_amdgcn_rsqf(rsv[ai * 4 + m] * (1.0f / D) + EPS);
                if (pn < 16) {
#pragma unroll
                    for (int bj = 0; bj < 2; ++bj) {
                        const f32x4 v0 = acc[ai][bj][m][0] * rs, v1 = acc[ai][bj][m][1] * rs;
                        if (ok) { u32x4 o; o[0] = cvt_pk_bf16(v0[0], v0[1]); o[1] = cvt_pk_bf16(v0[2], v0[3]); o[2] = cvt_pk_bf16(v1[0], v1[1]); o[3] = cvt_pk_bf16(v1[2], v1[3]);
                            *(u32x4*)(z + (size_t)row * ZW + col0 + bj * HALF) = o; }
                        if (pn >= 4 && pn < 12) {
                            float ss = v0[0] * v0[0] + v0[1] * v0[1] + v0[2] * v0[2] + v0[3] * v0[3] + v1[0] * v1[0] + v1[1] * v1[1] + v1[2] * v1[2] + v1[3] * v1[3];
                            ss = xsum16_32(ss);
                            if (fq == 0 && ok) ssqqk[(size_t)row * 64 + ((pn - 4) * 2 + bj) * 4 + wc] = ss;
                        }
                    }
                } else if (wc == 0 && fq == 0 && ok) {
                    *(f32x4*)(flog + (size_t)row * 8) = acc[ai][0][m][0] * rs; *(f32x4*)(flog + (size_t)row * 8 + 4) = acc[ai][0][m][1] * rs;
                }
            }
    }
};

struct EpiPlain {
    bf16_t* O;
    __device__ __forceinline__ void prefetch(const Unit&, int, int, float (&)[8]) const {}
    __device__ __forceinline__ void operator()(const f32x4 (&acc)[2][2][4][2], const Unit& u, int wr, int wc, int fr, int fq, const float (&rsv)[8]) const {
        const int row0 = u.pm * BM + wr * 64 + fr, col0 = u.pn * BM + wc * 32 + 8 * fq;
#pragma unroll
        for (int ai = 0; ai < 2; ++ai)
#pragma unroll
            for (int m = 0; m < 4; ++m) {
                const int row = row0 + ai * HALF + m * 16;
                if (row < M) {
#pragma unroll
                    for (int bj = 0; bj < 2; ++bj) {
                        const f32x4 v0 = acc[ai][bj][m][0], v1 = acc[ai][bj][m][1];
                        u32x4 o; o[0] = cvt_pk_bf16(v0[0], v0[1]); o[1] = cvt_pk_bf16(v0[2], v0[3]); o[2] = cvt_pk_bf16(v1[0], v1[1]); o[3] = cvt_pk_bf16(v1[2], v1[3]);
                        *(u32x4*)(O + (size_t)row * D + col0 + bj * HALF) = o;
                    }
                }
            }
    }
};

template <int MODE, int KSTEPS, int UNR>
__device__ __forceinline__ void skinny_phase(const Params& p, unsigned char* shm, int ctr_idx, int ntasks, const int wave_s) {
    unsigned char* ws = p.ws;
    int tid_ = phase_tid(wave_s);
    const int tid = tid_, wid = tid >> 6, lane = tid & 63, fr = lane & 15, quad = lane >> 4;
    f32x4* part = (f32x4*)shm;
    int* taskp = (int*)(shm + 16384);
    int* ctr = (int*)(ws + WS_CTR) + ctr_idx;
    const bf16_t* A = (MODE == 2) ? (const bf16_t*)(ws + WS_ACT) + (size_t)MX * DFF : (const bf16_t*)(ws + WS_HB) + (size_t)MX * D;
    const bf16_t* Bt = (const bf16_t*)(ws + (MODE == 1 ? WS_GU1 : MODE == 2 ? WS_D1 : WS_IN));
    constexpr int LDK = (MODE == 2) ? DFF : D;
    for (;;) {
        __syncthreads();
        if (tid == 0) *taskp = atomicAdd(ctr, 1);
        __syncthreads();
        const int cb = *taskp;
        if (cb >= ntasks) break;
        const int kbase = wid * KSTEPS * 32 + quad * 8;
        const bf16_t* ap = A + (size_t)fr * LDK + kbase;
        const int brow = (MODE == 1) ? ((cb >> 3) * 256 + (cb & 7) * 16 + fr) : cb * 16 + fr;
        const bf16_t* bp = Bt + (size_t)brow * LDK + kbase;
        f32x4 acc0 = {0.f, 0.f, 0.f, 0.f}, acc1 = {0.f, 0.f, 0.f, 0.f};
        for (int s0 = 0; s0 < KSTEPS; s0 += UNR) {
            bf16x8 av[UNR], b0[UNR], b1[UNR];
#pragma unroll
            for (int u = 0; u < UNR; ++u) { av[u] = *(const bf16x8*)(ap + (s0 + u) * 32); b0[u] = *(const bf16x8*)(bp + (s0 + u) * 32);
                if (MODE == 1) b1[u] = *(const bf16x8*)(bp + (size_t)128 * LDK + (s0 + u) * 32); }
#pragma unroll
            for (int u = 0; u < UNR; ++u) { acc0 = __builtin_amdgcn_mfma_f32_16x16x32_bf16(b0[u], av[u], acc0, 0, 0, 0);
                if (MODE == 1) acc1 = __builtin_amdgcn_mfma_f32_16x16x32_bf16(b1[u], av[u], acc1, 0, 0, 0); }
        }
        part[wid * 64 + lane] = acc0;
        if (MODE == 1) part[512 + wid * 64 + lane] = acc1;
        __syncthreads();
        if (wid == 0) {
            f32x4 a0 = part[lane], a1 = {0.f, 0.f, 0.f, 0.f};
#pragma unroll
            for (int w = 1; w < 8; ++w) a0 += part[w * 64 + lane];
            if (MODE == 1) { a1 = part[512 + lane];
#pragma unroll
                for (int w = 1; w < 8; ++w) a1 += part[512 + w * 64 + lane]; }
            const int row = MX + fr, c = cb * 16 + quad * 4;
            if (MODE == 1) {
                const float rs = rsqrtf(((const float*)(ws + WS_SSQ0))[row] * (1.0f / D) + EPS);
                u32x2 o; o[0] = cvt_pk_bf16(silu_mul(a0[0] * rs, a1[0] * rs), silu_mul(a0[1] * rs, a1[1] * rs)); o[1] = cvt_pk_bf16(silu_mul(a0[2] * rs, a1[2] * rs), silu_mul(a0[3] * rs, a1[3] * rs));
                *(u32x2*)((bf16_t*)(ws + WS_ACT) + (size_t)row * DFF + c) = o;
            } else if (MODE == 2) {
                const f32x4 v = *(const f32x4*)(p.in[1] + (size_t)fr * D + c) + a0 * 0.5f;
                *(f32x4*)((float*)(ws + WS_HMETA) + (size_t)fr * D + c) = v;
                u32x2 o; o[0] = cvt_pk_bf16(v[0], v[1]); o[1] = cvt_pk_bf16(v[2], v[3]);
                *(u32x2*)((bf16_t*)(ws + WS_HB) + (size_t)row * D + c) = o;
                float ss = v[0] * v[0] + v[1] * v[1] + v[2] * v[2] + v[3] * v[3];
                ss = xsum16_32(ss);
                if (quad == 0) atomicAdd((float*)(ws + WS_SSQ1) + row, ss);
            } else {
                const float rs = rsqrtf(((const float*)(ws + WS_SSQ1))[row] * (1.0f / D) + EPS);
                const f32x4 v = a0 * rs;
                if (cb < 256) {
                    u32x2 o; o[0] = cvt_pk_bf16(v[0], v[1]); o[1] = cvt_pk_bf16(v[2], v[3]);
                    *(u32x2*)((bf16_t*)(ws + WS_Z) + (size_t)row * ZW + c) = o;
                    if (cb >= 64 && cb < 192) {
                        float ss = v[0] * v[0] + v[1] * v[1] + v[2] * v[2] + v[3] * v[3];
                        ss = xsum16_32(ss);
                        if (quad == 0) atomicAdd((float*)(ws + WS_SSQQK) + (size_t)row * 64 + ((cb - 64) >> 3) * 4, ss);
                    }
                } else if (quad < 2) *(f32x4*)((float*)(ws + WS_FLOG) + (size_t)row * 8 + quad * 4) = v;
            }
        }
    }
}

struct TileDesc { const float* src; const float* gk; const float* sn; bf16_t* dst; int ldn, nvalid, k0, n0, dstK, drow0; };
constexpr int CT_LDB = 288  , CT_SLOT = 128 * CT_LDB;
__device__ __forceinline__ TileDesc cvt_decode(const Params& p, int ti) {
    constexpr int T_FF = 704, T_IN = 16 * 33, T_OUT = 16 * 16;
    unsigned char* ws = p.ws;
    TileDesc d; d.gk = nullptr; d.sn = nullptr;
    if (ti < 6 * T_FF) {
        const int job = ti / T_FF, r = ti - job * T_FF, layer = job / 3, kind = job - layer * 3;
        if (kind < 2) {
            const int tk = r / 44, tn = r - tk * 44;
            d.src = p.in[(layer ? 15 : 3) + kind]; d.dst = (bf16_t*)(ws + (layer ? WS_GU2 : WS_GU1)); d.gk = p.in[layer ? 14 : 2];
            d.ldn = DFF; d.nvalid = DFF; d.k0 = tk * 128; d.n0 = tn * 128; d.dstK = D; d.drow0 = tn * 256 + kind * 128;
        } else {
            const int tk = r / 16, tn = r - tk * 16;
            d.src = p.in[layer ? 17 : 5]; d.dst = (bf16_t*)(ws + (layer ? WS_D2 : WS_D1));
            d.ldn = D; d.nvalid = D; d.k0 = tk * 128; d.n0 = tn * 128; d.dstK = DFF; d.drow0 = tn * 128;
        }
    } else if (ti < 6 * T_FF + T_IN) {
        const int r = ti - 6 * T_FF, tk = r / 33, tn = r - tk * 33;
        d.src = p.in[7]; d.dst = (bf16_t*)(ws + WS_IN); d.gk = p.in[6];
        d.ldn = DIN; d.nvalid = DIN; d.k0 = tk * 128; d.n0 = tn * 128; d.dstK = D; d.drow0 = tn * 128;
    } else if (ti < 6 * T_FF + T_IN + T_OUT) {
        const int r = ti - 6 * T_FF - T_IN, tk = r >> 4, tn = r & 15;
        d.src = p.in[13]; d.dst = (bf16_t*)(ws + WS_OUT);
        d.ldn = D; d.nvalid = D; d.k0 = tk * 128; d.n0 = tn * 128; d.dstK = D; d.drow0 = tn * 128;
    } else {
        const int r = ti - 6 * T_FF - T_IN - T_OUT, g = r >> 2, tk = (r >> 1) & 1, tn = r & 1;
        d.src = p.in[11] + (size_t)g * 65536; d.dst = (bf16_t*)(ws + WS_POOL) + (size_t)g * 65536; d.sn = p.in[12] + g * 256;
        d.ldn = 256; d.nvalid = 256; d.k0 = tk * 128; d.n0 = tn * 128; d.dstK = 256; d.drow0 = tn * 128;
    }
    return d;
}
#define CVT_LOAD(d, v, gv) do { _Pragma("unroll") for (int _i = 0; _i < 8; ++_i) { const int idx = tid + _i * 512, k = idx >> 5, n = (d).n0 + (idx & 31) * 4; \
        v[_i] = (n < (d).nvalid) ? *(const f32x4*)((d).src + (size_t)((d).k0 + k) * (d).ldn + n) : (f32x4){0.f, 0.f, 0.f, 0.f}; \
        gv[_i] = (d).gk ? (d).gk[(d).k0 + k] : 1.0f; } } while (0)
#define CVT_PROCESS(cur, v, gv, MID) do { \
        _Pragma("unroll") for (int i = 0; i < 8; ++i) { const int idx = tid + i * 512, k = idx >> 5, n4 = idx & 31; \
            f32x4 sc = {1.f, 1.f, 1.f, 1.f}; if ((cur).sn) sc = *(const f32x4*)((cur).sn + (cur).n0 + n4 * 4); \
            const float g = gv[i]; u32x2 o; o[0] = cvt_pk_bf16(v[i][0] * g * sc[0], v[i][1] * g * sc[1]); o[1] = cvt_pk_bf16(v[i][2] * g * sc[2], v[i][3] * g * sc[3]); \
            *(u32x2*)(tile + k * CT_LDB + ((n4 * 8) ^ (((k >> 3) & 1) << 7))) = o; } \
        LDS_BARRIER(); \
        MID; \
        { const int w_ = tid >> 6, q_ = (tid >> 4) & 3, i_ = tid & 15; \
          _Pragma("unroll") for (int j = 0; j < 4; ++j) { const int kc = 4 * j + q_, kr = kc * 8 + (i_ >> 2); \
            LAS unsigned char* tp = (LAS unsigned char*)tile + kr * CT_LDB + ((32 * w_ + 8 * (i_ & 3)) ^ ((kc & 1) << 7)); \
            const s16x4 a = __builtin_amdgcn_ds_read_tr16_b64_v4i16((LAS s16x4*)tp), b = __builtin_amdgcn_ds_read_tr16_b64_v4i16((LAS s16x4*)(tp + 4 * CT_LDB)); \
            const bf16x8 o = {a[0], a[1], a[2], a[3], b[0], b[1], b[2], b[3]}; \
            *(bf16x8*)((cur).dst + (size_t)((cur).drow0 + 16 * w_ + i_) * (cur).dstK + (cur).k0 + kc * 8) = o; } } \
        LDS_BARRIER(); } while (0)

__device__ __forceinline__ void prep_phase(const Params& p, unsigned char* shm, const int wave_s) {
    unsigned char* tile = shm;
    unsigned char* ws = p.ws;
    int tid_ = phase_tid(wave_s);
    const int tid = tid_, wid = tid >> 6, lane = tid & 63;
    constexpr int T_ALL = 3 * 704;
    int ti = blockIdx.x;
    TileDesc cur = cvt_decode(p, ti);
    f32x4 v[8]; float gv[8];
    CVT_LOAD(cur, v, gv);
    { float* s1 = (float*)(ws + WS_SSQ1); float* s2 = (float*)(ws + WS_SSQ2); float* sq = (float*)(ws + WS_SSQQK);
      const int gt = blockIdx.x * 512 + tid, nth = gridDim.x * 512;
      for (int i = gt; i < MP; i += nth) { s1[i] = 0.f; s2[i] = 0.f; }
      for (int i = gt; i < (MX + NMETA) * 64; i += nth) sq[i] = 0.f;
      if (gt < 8) ((int*)(ws + WS_CTR))[gt] = 0; }
    { bf16_t* hb = (bf16_t*)(ws + WS_HB); float* ssq0 = (float*)(ws + WS_SSQ0);
      for (int row = blockIdx.x * 8 + wid; row < M; row += gridDim.x * 8) {
          const float* src = (row >= MX) ? p.in[1] + (size_t)(row - MX) * D : p.in[0] + (size_t)row * D;
          float ss = 0.f;
#pragma unroll
          for (int i = 0; i < 8; ++i) { const int c = i * 256 + lane * 4; const f32x4 x4 = *(const f32x4*)(src + c);
              ss += x4[0] * x4[0] + x4[1] * x4[1] + x4[2] * x4[2] + x4[3] * x4[3];
              u32x2 o; o[0] = cvt_pk_bf16(x4[0], x4[1]); o[1] = cvt_pk_bf16(x4[2], x4[3]); *(u32x2*)(hb + (size_t)row * D + c) = o; }
          ss += __shfl_xor(ss, 1); ss += __shfl_xor(ss, 2); ss += __shfl_xor(ss, 4); ss += __shfl_xor(ss, 8); ss += __shfl_xor(ss, 16); ss += __shfl_xor(ss, 32);
          if (lane == 0) ssq0[row] = ss;
      } }
    for (;;) {
        const int tn_ = ti + gridDim.x; const bool has_next = tn_ < T_ALL;
        TileDesc nx = cur; f32x4 vn[8]; float gn[8];
        if (has_next) { nx = cvt_decode(p, tn_); CVT_LOAD(nx, vn, gn); }
        CVT_PROCESS(cur, v, gv, (void)0);
        if (!has_next) break;
        cur = nx; ti = tn_;
#pragma unroll
        for (int i = 0; i < 8; ++i) { v[i] = vn[i]; gv[i] = gn[i]; }
    }
}

template <int WHICH> __device__ __forceinline__ int cvt_qmap(int n) {
    if (WHICH == 0) return n < 800 ? 4224 + n : 2112 + (n - 800);
    return 3520 + n;
}
template <int WHICH> __device__ __forceinline__ void cvt_queue(const Params& p, unsigned char* shm, int ctr_idx, int count, const int wave_s) {
    unsigned char* tile = shm;
    volatile int* slot = (volatile int*)(shm + CT_SLOT);
    int* ctr = (int*)(p.ws + WS_CTR) + ctr_idx;
    int tid_ = phase_tid(wave_s);
    const int tid = tid_;
    __syncthreads();
    if (tid == 0) { slot[0] = atomicAdd(ctr, 1); slot[1] = atomicAdd(ctr, 1); }
    __syncthreads();
    int n_cur = slot[0], n_nxt = slot[1];
    if (n_cur >= count) return;
    TileDesc cur = cvt_decode(p, cvt_qmap<WHICH>(n_cur));
    f32x4 v[8]; float gv[8];
    CVT_LOAD(cur, v, gv);
    for (;;) {
        const bool has_next = n_nxt < count;
        TileDesc nx = cur; f32x4 vn[8]; float gn[8];
        if (has_next) { nx = cvt_decode(p, cvt_qmap<WHICH>(n_nxt)); CVT_LOAD(nx, vn, gn); }
        if (tid == 0) slot[2] = atomicAdd(ctr, 1);
        int n_after = 0;
        CVT_PROCESS(cur, v, gv, n_after = slot[2]);
        if (!has_next) break;
        cur = nx; n_nxt = n_after;
#pragma unroll
        for (int i = 0; i < 8; ++i) { v[i] = vn[i]; gv[i] = gn[i]; }
    }
}

__device__ __forceinline__ void flog_phase(const Params& p, unsigned char* shm, const int wave_s) {
    unsigned char* ws = p.ws;
    int tid_ = phase_tid(wave_s);
    const int tid = tid_, wid = tid >> 6, lane = tid & 63, fr = lane & 15, quad = lane >> 4;
    f32x4* part = (f32x4*)shm;
    for (int t2 = blockIdx.x; t2 < 256; t2 += gridDim.x) {
        const int task = t2 * 2 + (wid >> 2), kq = wid & 3;
        const bf16_t* hp = (const bf16_t*)(ws + WS_HB) + (size_t)(task * 16 + fr) * D + kq * 512 + quad * 8;
        const bf16_t* wp = (const bf16_t*)(ws + WS_IN) + (size_t)(4096 + fr) * D + kq * 512 + quad * 8;
        f32x4 acc = {0.f, 0.f, 0.f, 0.f};
#pragma unroll
        for (int s0 = 0; s0 < 16; s0 += 8) {
            bf16x8 hv[8], wv[8];
#pragma unroll
            for (int u = 0; u < 8; ++u) { hv[u] = *(const bf16x8*)(hp + (s0 + u) * 32); wv[u] = *(const bf16x8*)(wp + (s0 + u) * 32); }
#pragma unroll
            for (int u = 0; u < 8; ++u) acc = __builtin_amdgcn_mfma_f32_16x16x32_bf16(wv[u], hv[u], acc, 0, 0, 0);
        }
        __syncthreads();
        part[wid * 64 + lane] = acc;
        __syncthreads();
        if ((wid & 3) == 0) {
            const f32x4 a = part[wid * 64 + lane] + part[(wid + 1) * 64 + lane] + part[(wid + 2) * 64 + lane] + part[(wid + 3) * 64 + lane];
            const int row = task * 16 + fr;
            const float rs = rsqrtf(((const float*)(ws + WS_SSQ1))[row] * (1.0f / D) + EPS);
            if (quad < 2) *(f32x4*)((float*)(ws + WS_FLOG) + (size_t)row * 8 + quad * 4) = a * rs;
        }
    }
}

__device__ __forceinline__ float log_sigmoid(float v) { return fminf(v, 0.f) - log1pf(expf(-fabsf(v))); }
template <int W> __device__ __forceinline__ void pooled_item(const bf16_t* __restrict__ z, bf16_t* __restrict__ pb  , int b, int t0  , int c0) {
    u32x4 r[W + 7];
#pragma unroll
    for (int i = 0; i < W + 7; ++i) { const int t = t0 - (W - 1) + i; r[i] = (t >= 0) ? *(const u32x4*)(z + (size_t)grow_of(b, t) * ZW + c0) : (u32x4){0u, 0u, 0u, 0u}; }
    float a[8] = {0.f, 0.f, 0.f, 0.f, 0.f, 0.f, 0.f, 0.f};
#pragma unroll
    for (int i = 0; i < W - 1; ++i)
#pragma unroll
        for (int e = 0; e < 4; ++e) { a[2 * e] += bf_lo(r[i][e]); a[2 * e + 1] += bf_hi(r[i][e]); }
#pragma unroll
    for (int i = 0; i < 8; ++i) {
        const u32x4 cur = r[W - 1 + i];
#pragma unroll
        for (int e = 0; e < 4; ++e) { a[2 * e] += bf_lo(cur[e]); a[2 * e + 1] += bf_hi(cur[e]); }
        const int t = t0 + i, cnt = (t + 1 < W) ? t + 1 : W;
        const float inv = 1.0f / (float)cnt;
        u32x4 o;
#pragma unroll
        for (int e = 0; e < 4; ++e) o[e] = cvt_pk_bf16(a[2 * e] * inv - bf_lo(cur[e]), a[2 * e + 1] * inv - bf_hi(cur[e]));
        *(u32x4*)(pb + (size_t)(t - NMETA) * 1024 + c0) = o;
#pragma unroll
        for (int e = 0; e < 4; ++e) { a[2 * e] -= bf_lo(r[i][e]); a[2 * e + 1] -= bf_hi(r[i][e]); }
    }
}
__device__ __forceinline__ void mid_phase(const Params& p, unsigned char* shm, const int wave_s) {
    unsigned char* ws = p.ws;
    int tid_ = phase_tid(wave_s);
    const int tid = tid_, lane = tid & 63, wid = tid >> 6;
    const bf16_t* z = (const bf16_t*)(ws + WS_Z);
    if (blockIdx.x < 32) {
        const int bh = blockIdx.x, b = bh >> 3, h = bh & 7;
        const float* flog = (const float*)(ws + WS_FLOG); float* cum = (float*)(ws + WS_CUM);
        float* wtot = (float*)shm;
        const float bf = p.in[8][h];
        const int t0 = tid * 5;
        float lf[5]; float tot = 0.f;
#pragma unroll
        for (int i = 0; i < 5; ++i) { const int t = t0 + i; lf[i] = (t < L) ? log_sigmoid(flog[(size_t)grow_of(b, t) * 8 + h] + bf) : 0.f; tot += lf[i]; }
        float inc = tot;
#pragma unroll
        for (int o = 1; o < 64; o <<= 1) { const float y = __shfl_up(inc, o); if (lane >= o) inc += y; }
        if (lane == 63) wtot[wid] = inc;
        __syncthreads();
        float run = inc - tot;
        for (int w = 0; w < wid; ++w) run += wtot[w];
#pragma unroll
        for (int i = 0; i < 5; ++i) { const int t = t0 + i; run += lf[i]; if (t < L) cum[bh * CUML + t] = run; }
    }
    if (blockIdx.x < 32) {
        __syncthreads();
        if (tid == 0) { __builtin_amdgcn_fence(__ATOMIC_RELEASE, "agent"); asm volatile("s_waitcnt vmcnt(0)" ::: "memory");
            __hip_atomic_fetch_add((int*)(ws + WS_CTR) + 7, 1, __ATOMIC_RELAXED, __HIP_MEMORY_SCOPE_AGENT); }
    }
}
__device__ __forceinline__ void pooled_for_unit(const Params& p, const int upm, const int upn, const int wave_s) {
    unsigned char* ws = p.ws;
    const int tid = phase_tid(wave_s);
    const bf16_t* z = (const bf16_t*)(ws + WS_Z); bf16_t* pooled = (bf16_t*)(ws + WS_POOLED);
    const int b = upm >> 3, g = upn;
    bf16_t* pb = pooled + (size_t)b * SEQ * 1024;
#pragma unroll
    for (int i = 0; i < 2; ++i) { const int idx = tid + i * 512, rc = idx >> 5, cc = idx & 31;
        const int t0 = NMETA + (upm & 7) * 256 + rc * 8, c0 = g * 256 + cc * 8;
        if (g == 0) pooled_item<2>(z, pb, b, t0, c0); else if (g == 1) pooled_item<4>(z, pb, b, t0, c0); else if (g == 2) pooled_item<8>(z, pb, b, t0, c0); else pooled_item<16>(z, pb, b, t0, c0); }
}

constexpr int V_LDB = 288  ;
constexpr int KS_LD = 144  , VT_LD = 72, AT_VT = 64 * KS_LD * 2, AT_KSC = AT_VT + 128 * VT_LD * 2, AT_KCM = AT_KSC + 256, AT_BUF = AT_KCM + 256  , AT_ITEM = 2 * AT_BUF;
constexpr int N_ITEMS = 32 * 16;
__device__ __forceinline__ void attn_phase(const Params& p, unsigned char* shm, int ctr_idx, const int wave_s) {
    unsigned char* ws = p.ws;
    int tid_ = phase_tid(wave_s);
    const int tid = tid_, wid = tid >> 6, lane = tid & 63, fr = lane & 15, quad = lane >> 4;
    int* itemp = (int*)(shm + AT_ITEM);
    const bf16_t* z = (const bf16_t*)(ws + WS_Z); const float* ssqqk = (const float*)(ws + WS_SSQQK); const float* cum = (const float*)(ws + WS_CUM);
    bf16_t* mix = (bf16_t*)(ws + WS_MIX); int* ctr = (int*)(ws + WS_CTR) + ctr_idx;
    const float* gq = p.in[9]; const float* gkn = p.in[10];
    const float LOG2E = 1.4426950408889634f;
    for (;;) {
        __syncthreads();
        if (tid == 0) *itemp = atomicAdd(ctr, 1);
        __syncthreads();
        const int item = *itemp;
        if (item >= N_ITEMS) break;
        const int j = 16 - item / 32, bh = item & 31, b = bh >> 3, h = bh & 7;
        const int rowbase = 16 + 128 * (j - 1), ntiles = 2 * j + 1;
        const bool wvalid = true;
        const int qr0 = rowbase + 16 * wid;
        const int qrow = qr0 + fr; const size_t grow = (size_t)b * SEQ + (qrow - NMETA);
        const f32x4 qss = *(const f32x4*)(ssqqk + grow * 64 + h * 4);
        const float qs = rsqrtf((qss[0] + qss[1] + qss[2] + qss[3]) * (1.0f / DHD) + EPS) * 0.08838834764831845f;
        bf16x8 qf[4]; float gmax = 0.f;
#pragma unroll
        for (int ks = 0; ks < 4; ++ks) { const int d0 = ks * 32 + quad * 8;
            const u32x4 raw = *(const u32x4*)(z + grow * ZW + 1024 + h * DHD + d0);
            const f32x4 a0 = *(const f32x4*)(gq + d0), a1 = *(const f32x4*)(gq + d0 + 4), b0 = *(const f32x4*)(gkn + d0), b1 = *(const f32x4*)(gkn + d0 + 4);
            u32x4 o;
            o[0] = cvt_pk_bf16(bf_lo(raw[0]) * a0[0] * b0[0] * qs, bf_hi(raw[0]) * a0[1] * b0[1] * qs); o[1] = cvt_pk_bf16(bf_lo(raw[1]) * a0[2] * b0[2] * qs, bf_hi(raw[1]) * a0[3] * b0[3] * qs);
            o[2] = cvt_pk_bf16(bf_lo(raw[2]) * a1[0] * b1[0] * qs, bf_hi(raw[2]) * a1[1] * b1[1] * qs); o[3] = cvt_pk_bf16(bf_lo(raw[3]) * a1[2] * b1[2] * qs, bf_hi(raw[3]) * a1[3] * b1[3] * qs);
#pragma unroll
            for (int e = 0; e < 4; ++e) gmax = fmaxf(gmax, fmaxf(fabsf(a0[e] * b0[e]), fabsf(a1[e] * b1[e])));
            qf[ks] = __builtin_bit_cast(bf16x8, o); }
        gmax = fmaxf(gmax, __shfl_xor(gmax, 16)); gmax = fmaxf(gmax, __shfl_xor(gmax, 32));
        const float Coff = gmax * (128.0f * 0.08838834764831845f);
        const float cumq = (cum[bh * CUML + qrow] - Coff) * LOG2E;
        const int vlane = (8 * quad + (fr >> 2)) * V_LDB + ((fr & 3) >> 1) * 16 + 8 * (fr & 1);
        f32x4 O[8];
#pragma unroll
        for (int i = 0; i < 8; ++i) O[i] = (f32x4){0.f, 0.f, 0.f, 0.f};
        float lsum = 0.f;
        u32x4 kreg0[2], vreg0[2], kreg1[2], vreg1[2]; f32x4 kss_r0 = {0.f, 0.f, 0.f, 0.f}, kss_r1 = {0.f, 0.f, 0.f, 0.f}; float kcm_r0 = 0.f, kcm_r1 = 0.f;
#define AT_PREFETCH(kt, R) do { _Pragma("unroll") for (int _i = 0; _i < 2; ++_i) { const int idx = tid + _i * 512, key = idx >> 4, ch = idx & 15; int gkey = (kt) * 64 + key; gkey = gkey < L ? gkey : L - 1; \
            const bf16_t* rp = z + (size_t)grow_of(b, gkey) * ZW + h * DHD + ch * 8; kreg##R[_i] = *(const u32x4*)(rp + 2048); vreg##R[_i] = *(const u32x4*)(rp + 3072); } \
            if (tid < 64) { int gkey = (kt) * 64 + tid; gkey = gkey < L ? gkey : L - 1; kss_r##R = *(const f32x4*)(ssqqk + (size_t)grow_of(b, gkey) * 64 + (8 + h) * 4); kcm_r##R = cum[bh * CUML + gkey]; } } while (0)
#define AT_WRITE(bufp, R) do { bf16_t* Ks_ = (bf16_t*)(bufp); unsigned char* Vb_ = (bufp) + AT_VT; \
            _Pragma("unroll") for (int i = 0; i < 2; ++i) { const int idx = tid + i * 512, key = idx >> 4, ch = idx & 15; \
                const int rho = (key & 32) + ((key >> 2) & 1) * 16 + ((key & 31) >> 3) * 4 + (key & 3); \
                *(u32x4*)(Ks_ + rho * KS_LD + ch * 8) = kreg##R[i]; \
                *(u32x4*)(Vb_ + key * V_LDB + ((ch ^ (((key >> 3) & 1) << 3)) << 4)) = vreg##R[i]; } \
            if (tid < 64) { ((float*)((bufp) + AT_KSC))[tid] = rsqrtf((kss_r##R[0] + kss_r##R[1] + kss_r##R[2] + kss_r##R[3]) * (1.0f / DHD) + EPS) * LOG2E; ((float*)((bufp) + AT_KCM))[tid] = kcm_r##R * LOG2E; } } while (0)
        auto tile_compute = [&](const int kt) __attribute__((always_inline)) {
            unsigned char* bufc = shm + (kt & 1) * AT_BUF;
            const bf16_t* Ks = (const bf16_t*)bufc;
            LAS unsigned char* vA = (LAS unsigned char*)(bufc + AT_VT) + vlane + (quad & 1) * 128; LAS unsigned char* vB = (LAS unsigned char*)(bufc + AT_VT) + vlane - (quad & 1) * 128;
            const float* kscl = (const float*)(bufc + AT_KSC); const float* kcm = (const float*)(bufc + AT_KCM);
            if (kt * 64 <= qr0 + 15) {
                f32x4 S[4];
#pragma unroll
                for (int blk = 0; blk < 4; ++blk) { S[blk] = (f32x4){0.f, 0.f, 0.f, 0.f};
#pragma unroll
                    for (int ks = 0; ks < 4; ++ks) { const bf16x8 kf = *(const bf16x8*)(Ks + (blk * 16 + fr) * KS_LD + ks * 32 + quad * 8);
                        S[blk] = __builtin_amdgcn_mfma_f32_16x16x32_bf16(kf, qf[ks], S[blk], 0, 0, 0); } }
                const bool need_mask = (kt * 64 + 63 > qr0);
                const f32x4 cq4 = {cumq, cumq, cumq, cumq};
#pragma unroll
                for (int blk = 0; blk < 4; ++blk) { const int kb = (blk >> 1) * 32 + quad * 8 + (blk & 1) * 4;
                    const f32x4 sc = *(const f32x4*)(kscl + kb), cm = *(const f32x4*)(kcm + kb);
                    S[blk] = S[blk] * sc + (cq4 - cm); }
                if (need_mask) {
#pragma unroll
                    for (int blk = 0; blk < 4; ++blk) { const int kb = (blk >> 1) * 32 + quad * 8 + (blk & 1) * 4;
#pragma unroll
                        for (int i = 0; i < 4; ++i) if (kt * 64 + kb + i > qrow) S[blk][i] = -1e30f; } }
#pragma unroll
                for (int blk = 0; blk < 4; ++blk)
#pragma unroll
                    for (int i = 0; i < 4; ++i) S[blk][i] = __builtin_amdgcn_exp2f(S[blk][i]);
                { const f32x4 s4 = (S[0] + S[1]) + (S[2] + S[3]); lsum += (s4[0] + s4[1]) + (s4[2] + s4[3]); }
                bf16x8 pf[2];
#pragma unroll
                for (int G = 0; G < 2; ++G) { u32x4 o; o[0] = cvt_pk_bf16(S[2 * G][0], S[2 * G][1]); o[1] = cvt_pk_bf16(S[2 * G][2], S[2 * G][3]);
                    o[2] = cvt_pk_bf16(S[2 * G + 1][0], S[2 * G + 1][1]); o[3] = cvt_pk_bf16(S[2 * G + 1][2], S[2 * G + 1][3]); pf[G] = __builtin_bit_cast(bf16x8, o); }
#pragma unroll
                for (int db = 0; db < 8; ++db)
#pragma unroll
                    for (int G = 0; G < 2; ++G) { LAS unsigned char* vp = (db < 4 ? vA : vB) + (32 * G) * V_LDB + 32 * db;
                        const s16x4 v0 = __builtin_amdgcn_ds_read_tr16_b64_v4i16((LAS s16x4*)vp), v1 = __builtin_amdgcn_ds_read_tr16_b64_v4i16((LAS s16x4*)(vp + 4 * V_LDB));
                        const bf16x8 vf = {v0[0], v0[1], v0[2], v0[3], v1[0], v1[1], v1[2], v1[3]};
                        O[db] = __builtin_amdgcn_mfma_f32_16x16x32_bf16(vf, pf[G], O[db], 0, 0, 0); }
            }
        };
        AT_PREFETCH(0, 0);
        AT_WRITE(shm, 0);
        AT_PREFETCH(1, 1);
        AT_PREFETCH(2, 0);
        LDS_BARRIER();
        for (int kt = 0; kt < ntiles; kt += 2) {
            if (kt + 1 < ntiles) AT_WRITE(shm + AT_BUF, 1);
            if (kt + 3 < ntiles) AT_PREFETCH(kt + 3, 1);
            tile_compute(kt);
            LDS_BARRIER();
            if (kt + 1 < ntiles) {
                if (kt + 2 < ntiles) AT_WRITE(shm, 0);
                if (kt + 4 < ntiles) AT_PREFETCH(kt + 4, 0);
                tile_compute(kt + 1);
                LDS_BARRIER();
            }
        }
#undef AT_PREFETCH
#undef AT_WRITE
        lsum = xsum16_32(lsum);
        const float inv = 1.0f / lsum;
        if (wvalid) {
#pragma unroll
            for (int db = 0; db < 8; ++db) { u32x2 o; o[0] = cvt_pk_bf16(O[db][0] * inv, O[db][1] * inv); o[1] = cvt_pk_bf16(O[db][2] * inv, O[db][3] * inv);
                *(u32x2*)(mix + grow * D + 1024 + h * DHD + db * 16 + quad * 4) = o; }
        }
    }
}

constexpr int LDS_BYTES = STAGE_BYTES + 16;
__global__ __launch_bounds__(512, 2) void hymba_fwd(Params p) {
    extern __shared__ __attribute__((aligned(16))) unsigned char shm[];
    LAS unsigned char* lds = (LAS unsigned char*)shm;
    cg::grid_group grid = cg::this_grid();
    unsigned char* ws = p.ws;
    bf16_t* hb = (bf16_t*)(ws + WS_HB); bf16_t* act = (bf16_t*)(ws + WS_ACT); bf16_t* z = (bf16_t*)(ws + WS_Z); bf16_t* mix = (bf16_t*)(ws + WS_MIX);
    float* hmeta = (float*)(ws + WS_HMETA);
    float* ssq0 = (float*)(ws + WS_SSQ0); float* ssq1 = (float*)(ws + WS_SSQ1); float* ssq2 = (float*)(ws + WS_SSQ2);
    const int G = gridDim.x, c = blockIdx.x;
    const int wave_s = __builtin_amdgcn_readfirstlane((int)threadIdx.x >> 6);
    StaticOrder S;
    if (phase_tid(wave_s) == 0) { *(volatile LAS unsigned*)(lds + STAGE_BYTES) = 0u; *(volatile LAS unsigned*)(lds + STAGE_BYTES + 4) = 0u; }
    __syncthreads();
    const XcdBarrier xb = xcd_barrier_post((unsigned*)(ws + WS_BAR), (volatile LAS unsigned*)(lds + STAGE_BYTES), wave_s);

    prep_phase(p, shm, wave_s);
    if (p.ws == nullptr) grid.sync();
    xcd_barrier(xb, wave_s);
    { Gemm g{hb, (const bf16_t*)(ws + WS_GU1), D, D, D, 0}; S.init(32, 44, G, c); EpiSwiGLU E{ssq0, act}; gemm_phase(lds, g, S, E, wave_s);
    }
    skinny_phase<1, 8, 8>(p, shm, 1, 352, wave_s);
    cvt_queue<0>(p, shm, 4, 800 + 1408, wave_s);
    xcd_barrier(xb, wave_s);
    { Gemm g{act, (const bf16_t*)(ws + WS_D1), DFF, DFF, DFF, 0}; S.init(32, 8, G, c); EpiRes<2> E{p.in[0], p.in[1], p.out, hmeta, hb, ssq1}; gemm_phase(lds, g, S, E, wave_s); }
    skinny_phase<2, 22, 11>(p, shm, 2, 128, wave_s);
    xcd_barrier(xb, wave_s);
    { Gemm g{hb, (const bf16_t*)(ws + WS_IN), D, D, D, 0}; S.init(32, 16, G, c); EpiZ E{ssq1, z, (float*)(ws + WS_FLOG), (float*)(ws + WS_SSQQK)}; gemm_phase(lds, g, S, E, wave_s); }
    skinny_phase<3, 8, 8>(p, shm, 3, 257, wave_s);
    flog_phase(p, shm, wave_s);
    xcd_barrier(xb, wave_s);
    mid_phase(p, shm, wave_s);
    { Gemm g{(const bf16_t*)(ws + WS_POOLED), (const bf16_t*)(ws + WS_POOL), 1024, 256, 256, 512}; S.init(32, 4, G, c); EpiPlain E{mix};
      for (int i = 0;; ++i) { Unit u; if (!S.next(i, u)) break; pooled_for_unit(p, u.pm, u.pn, wave_s); }
      asm volatile("s_waitcnt vmcnt(0)" ::: "memory"); __syncthreads();
      gemm_phase(lds, g, S, E, wave_s); }
    { if (phase_tid(wave_s) == 0) { int* flag = (int*)(ws + WS_CTR) + 7; unsigned sp = 0;
          while (__hip_atomic_load(flag, __ATOMIC_RELAXED, __HIP_MEMORY_SCOPE_AGENT) < 32) { __builtin_amdgcn_s_sleep(1); if (++sp > (1u << 22)) break; }
          __builtin_amdgcn_fence(__ATOMIC_ACQUIRE, "agent"); asm volatile("s_waitcnt vmcnt(0)" ::: "memory"); }
      __syncthreads(); }
    attn_phase(p, shm, 0, wave_s);
    xcd_barrier(xb, wave_s);
    { Gemm g{mix, (const bf16_t*)(ws + WS_OUT), D, D, D, 0}; S.init(32, 8, G, c); EpiRes<6> E{p.in[0], p.in[1], p.out, hmeta, hb, ssq2}; gemm_phase(lds, g, S, E, wave_s); }
    xcd_barrier(xb, wave_s);
    { Gemm g{hb, (const bf16_t*)(ws + WS_GU2), D, D, D, 0}; S.init(32, 44, G, c); EpiSwiGLU E{ssq2, act}; gemm_phase(lds, g, S, E, wave_s); }
    cvt_queue<1>(p, shm, 5, 704, wave_s);
    xcd_barrier(xb, wave_s);
    { Gemm g{act, (const bf16_t*)(ws + WS_D2), DFF, DFF, DFF, 0}; S.init(32, 8, G, c); EpiRes<8> E{p.in[0], p.in[1], p.out, hmeta, hb, ssq2}; gemm_phase(lds, g, S, E, wave_s); }
}

extern "C" void kernel_launch(void* const* d_in, const int* in_sizes, int n_in, void* d_out, int out_size, void* d_ws, size_t ws_size, hipStream_t stream) {
    static int grid_blocks = 0;
    if (grid_blocks == 0) {
        if (n_in != 18 || ws_size < WS_END) { fprintf(stderr, "kernel_launch: need 18 inputs and %zu bytes of workspace (got %d, %zu)\n", (size_t)WS_END, n_in, ws_size); grid_blocks = -1; return; }
        int dev = 0, cus = 0, per_cu = 0;
        (void)hipGetDevice(&dev);
        (void)hipDeviceGetAttribute(&cus, hipDeviceAttributeMultiprocessorCount, dev);
        (void)hipFuncSetAttribute((const void*)hymba_fwd, hipFuncAttributeMaxDynamicSharedMemorySize, LDS_BYTES);
        (void)hipOccupancyMaxActiveBlocksPerMultiprocessor(&per_cu, (const void*)hymba_fwd, 512, LDS_BYTES);
        if (per_cu < 1) per_cu = 1;
        grid_blocks = cus * per_cu;
    }
    if (grid_blocks < 0) return;
    if (hipMemsetAsync((char*)d_ws + WS_BAR, 0, XCD_BAR_WORDS * 4, stream) != hipSuccess) { fprintf(stderr, "memset failed\n"); return; }
    Params p{};
    for (int i = 0; i < 18; ++i) p.in[i] = (const float*)d_in[i];
    p.out = (float*)d_out; p.ws = (unsigned char*)d_ws;
    void* args[] = {&p};
    hipError_t e = hipLaunchCooperativeKernel((const void*)hymba_fwd, dim3(grid_blocks), dim3(512), args, LDS_BYTES, stream);
    if (e != hipSuccess) fprintf(stderr, "cooperative launch failed: %s (grid %d)\n", hipGetErrorString(e), grid_blocks);
}
```

```cpp
#include <hip/hip_runtime.h>
#include <hip/hip_cooperative_groups.h>
#include <cstdio>
namespace cg = cooperative_groups;

#define LAS __attribute__((address_space(3)))
typedef unsigned short bf16_t;
typedef short bf16x8 __attribute__((ext_vector_type(8)));
typedef float f32x4 __attribute__((ext_vector_type(4)));
typedef unsigned u32x4 __attribute__((ext_vector_type(4)));
typedef unsigned u32x2 __attribute__((ext_vector_type(2)));
typedef short s16x4 __attribute__((ext_vector_type(4)));

constexpr int D = 2048, NB = 4, SEQ = 2048, NMETA = 16, L = NMETA + SEQ  , MX = NB * SEQ  , M = MX + NMETA  , MP = 8448;
constexpr int DFF = 5632, DIN = 4104, NH = 8, DHD = 128, ZW = 4096  , CUML = 2112;
constexpr float EPS = 1e-6f;

constexpr size_t al256(size_t x) { return (x + 255) & ~(size_t)255; }
constexpr size_t WS_GU1 = 0;
constexpr size_t WS_D1 = WS_GU1 + (size_t)2 * DFF * D * 2;
constexpr size_t WS_IN = WS_D1 + (size_t)D * DFF * 2;
constexpr size_t WS_OUT = WS_IN + (size_t)4352 * D * 2;
constexpr size_t WS_POOL = WS_OUT + (size_t)D * D * 2;
constexpr size_t WS_GU2 = WS_POOL + (size_t)1024 * 256 * 2;
constexpr size_t WS_D2 = WS_GU2 + (size_t)2 * DFF * D * 2;
constexpr size_t WS_HB = WS_D2 + (size_t)D * DFF * 2;
constexpr size_t WS_ACT = WS_HB + (size_t)MP * D * 2;
constexpr size_t WS_Z = WS_ACT;
constexpr size_t WS_POOLED = WS_Z + (size_t)MP * ZW * 2;
constexpr size_t WS_MIX = WS_ACT + (size_t)MP * DFF * 2;
constexpr size_t WS_HMETA = WS_MIX + (size_t)MP * D * 2;
constexpr size_t WS_FLOG = WS_HMETA + (size_t)NMETA * D * 4;
constexpr size_t WS_CUM = WS_FLOG + (size_t)MP * 8 * 4;
constexpr size_t WS_SSQ0 = WS_CUM + (size_t)32 * CUML * 4;
constexpr size_t WS_SSQ1 = WS_SSQ0 + (size_t)MP * 4;
constexpr size_t WS_SSQ2 = WS_SSQ1 + (size_t)MP * 4;
constexpr size_t WS_SSQQK = WS_SSQ2 + (size_t)MP * 4;
constexpr size_t WS_CTR = WS_SSQQK + (size_t)MP * 64 * 4;
constexpr size_t WS_BAR = WS_CTR + 256;
constexpr size_t WS_END = WS_BAR + 3456 * 4;
static_assert(WS_POOLED + (size_t)MP * 1024 * 2 <= WS_MIX, "z + pooled must fit in the act region");

struct Params { const float* in[18]; float* out; unsigned char* ws; };

__device__ __forceinline__ unsigned cvt_pk_bf16(float lo, float hi) { unsigned r; asm volatile("v_cvt_pk_bf16_f32 %0, %1, %2" : "=v"(r) : "v"(lo), "v"(hi)); return r; }
#define LDS_BARRIER() do { asm volatile("s_waitcnt lgkmcnt(0)" ::: "memory"); __builtin_amdgcn_s_barrier(); asm volatile("" ::: "memory"); } while (0)
__device__ __forceinline__ int phase_tid(int wave_s) { int lane; asm volatile("v_mbcnt_lo_u32_b32 %0, -1, 0\n\tv_mbcnt_hi_u32_b32 %0, -1, %0" : "=v"(lane)); return wave_s * 64 + lane; }
__device__ __forceinline__ float bf_lo(unsigned u) { return __uint_as_float(u << 16); }
__device__ __forceinline__ float bf_hi(unsigned u) { return __uint_as_float(u & 0xffff0000u); }
__device__ __forceinline__ int grow_of(int b, int pos) { return pos < NMETA ? MX + pos : b * SEQ + pos - NMETA; }
__device__ __forceinline__ float xsum16_32(float v) { v += __shfl_xor(v, 16); v += __shfl_xor(v, 32); return v; }


#define XB_TMO      128
#define XB_XCNT(j)  (256  + 64 * (j))
#define XB_XSUB(j)  (1280 + 64 * (j))
#define XB_XGEN(j)  (2304 + 64 * (j))
#define XB_TOP      3328
#define XB_TOPGEN   3392
#define XCD_BAR_WORDS 3456
#define XB_SPIN_CAP (1u << 18)
__device__ __forceinline__ unsigned xb_ld(unsigned* p)              { return __hip_atomic_load(p, __ATOMIC_RELAXED, __HIP_MEMORY_SCOPE_AGENT); }
__device__ __forceinline__ unsigned xb_add(unsigned* p, unsigned v) { return __hip_atomic_fetch_add(p, v, __ATOMIC_RELAXED, __HIP_MEMORY_SCOPE_AGENT); }
__device__ __forceinline__ unsigned xb_xcc_id() { return (unsigned)__builtin_amdgcn_s_getreg((3 << 11) | 20) & 0xFu; }
#define XB_SPIN(cond, bar) do { unsigned _sp = 0; while (cond) { __builtin_amdgcn_s_sleep(1); \
    if ((++_sp & 255u) == 0u) { if (xb_ld(&(bar)[XB_TMO])) break; if (_sp > XB_SPIN_CAP) { atomicAdd(&(bar)[XB_TMO], 1u); break; } } } } while (0)
struct XcdBarrier { unsigned* bar; unsigned x; volatile LAS unsigned* st; };
__device__ __forceinline__ XcdBarrier xcd_barrier_post(unsigned* bar, volatile LAS unsigned* st, const int wave_s) {
    XcdBarrier b; b.bar = bar; b.x = xb_xcc_id(); b.st = st;
    if (phase_tid(wave_s) == 0) (void)xb_add(&bar[XB_XCNT(b.x)], 1u);
    return b;
}
__device__ __forceinline__ void xcd_barrier_complete(unsigned* bar, unsigned x, unsigned& nloc, unsigned& nx) {
    const unsigned G = gridDim.x * gridDim.y * gridDim.z;
    unsigned sum, cnt, mine, sp = 0u;
    for (;;) {
        sum = 0u; cnt = 0u; mine = 0u;
#pragma unroll
        for (unsigned j = 0; j < 16; ++j) { const unsigned c = xb_ld(&bar[XB_XCNT(j)]); sum += c; cnt += (c > 0u) ? 1u : 0u; mine = (j == x) ? c : mine; }
        if (sum == G) break;
        __builtin_amdgcn_s_sleep(1);
        if ((++sp & 255u) == 0u) { if (xb_ld(&bar[XB_TMO])) break; if (sp > XB_SPIN_CAP) { atomicAdd(&bar[XB_TMO], 1u); break; } }
    }
    nloc = mine > 0u ? mine : 1u; nx = cnt > 0u ? cnt : 1u;
}
__device__ __forceinline__ void xcd_barrier(const XcdBarrier& b, const int wave_s) {
    asm volatile("s_waitcnt vmcnt(0)" ::: "memory");
    __syncthreads();
    if (phase_tid(wave_s) == 0) {
        unsigned* bar = b.bar;
        __builtin_amdgcn_s_waitcnt(0);
        unsigned nloc = b.st[0], nx = b.st[1];
        if (nloc == 0u) { xcd_barrier_complete(bar, b.x, nloc, nx); b.st[0] = nloc; b.st[1] = nx; }
        const unsigned old = xb_add(&bar[XB_XSUB(b.x)], 1u);
        const unsigned gen = old / nloc;
        if (old + 1u == (gen + 1u) * nloc) {
            __builtin_amdgcn_fence(__ATOMIC_RELEASE, "agent");
            asm volatile("s_waitcnt vmcnt(0)" ::: "memory");
            const unsigned og = xb_add(&bar[XB_TOP], 1u);
            const unsigned tg = og / nx;
            if (og + 1u == (tg + 1u) * nx) xb_add(&bar[XB_TOPGEN], 1u);
            else XB_SPIN(xb_ld(&bar[XB_TOPGEN]) == tg, bar);
            __builtin_amdgcn_fence(__ATOMIC_ACQUIRE, "agent");
            xb_add(&bar[XB_XGEN(b.x)], 1u);
            asm volatile("s_waitcnt vmcnt(0)" ::: "memory");
        } else {
            XB_SPIN(xb_ld(&bar[XB_XGEN(b.x)]) == gen, bar);
            __builtin_amdgcn_fence(__ATOMIC_ACQUIRE, "agent");
            asm volatile("s_waitcnt vmcnt(0)" ::: "memory");
        }
    }
    __syncthreads();
}

constexpr int BM = 256, BK = 64, HALF = 128, HTB = HALF * BK * 2, STAGE_BYTES = 8 * HTB, NXCD = 8, WGM = 4;
__device__ __forceinline__ int lds_byte(int r, int c) { const int st = (r >> 4) * 2 + (c >> 5), rr = r & 15, cc = c & 31, ob = rr * 64 + cc * 2; return st * 1024 + (ob ^ (((ob >> 9) & 1) << 5)); }
__device__ __forceinline__ void stage_rc(int b, int& R, int& C) { const int st = b / 1024, sb = b % 1024, swz = sb ^ (((sb >> 9) & 1) << 5); R = (st >> 1) * 16 + swz / 64; C = (st & 1) * 32 + (swz % 64) / 2; }
__device__ __forceinline__ int perm32(int rho) { const int n = rho >> 4, i = rho & 15; return 8 * (i >> 2) + 4 * n + (i & 3); }

struct Unit { int pm, pn; };
struct Gemm { const bf16_t* A; const bf16_t* Bt; int lda, ldb, K, a_pn_off; };

struct StaticOrder {
    int nM, nN, nwg, G, c;
    __device__ __forceinline__ void init(int nM_, int nN_, int G_, int c_) { nM = nM_; nN = nN_; nwg = nM * nN; G = G_; c = c_; }
    __device__ __forceinline__ bool next(int i, Unit& u) const {
        const long Lx = (long)i * G + c; if (Lx >= nwg) return false;
        int wgid = (int)Lx; { const int q = nwg / NXCD, r = nwg % NXCD, xcd = wgid % NXCD, off = wgid / NXCD; wgid = (xcd < r ? xcd * (q + 1) : r * (q + 1) + (xcd - r) * q) + off; }
        const int nig = WGM * nN, gid = wgid / nig, fm = gid * WGM, gsz = (nM - fm) < WGM ? (nM - fm) : WGM;
        u.pm = fm + ((wgid % nig) % gsz); u.pn = (wgid % nig) / gsz; return true;
    }
};

template <class Epi>
__device__ __forceinline__ void gemm_phase(LAS unsigned char* lds, const Gemm g, const StaticOrder& S, const Epi& E, const int wave_s) {
    int tid_ = phase_tid(wave_s);
    const int tid = tid_, wid = __builtin_amdgcn_readfirstlane(tid >> 6), lane = tid & 63, wr = wid >> 2, wc = wid & 3, fr = lane & 15, fq = lane >> 4;
    const int K = g.K, nt = K / BK;
    unsigned voffA[2], voffB[2];
#pragma unroll
    for (int i = 0; i < 2; ++i) { int R, C; stage_rc(tid * 16 + i * 8192, R, C); const int Rb = (R & ~31) + perm32(R & 31);
        voffA[i] = (unsigned)(R * g.lda + C) * 2u; voffB[i] = (unsigned)(Rb * g.ldb + C) * 2u; }
    const size_t kstep = (size_t)(BK * 2);
    const size_t hstepA = (size_t)HALF * g.lda * 2, hstepB = (size_t)HALF * g.ldb * 2;
    const size_t tstepA = 2 * hstepA, tstepB = 2 * hstepB;
    const unsigned ldsw = (unsigned)wid * 1024u;
    const int aoff = lds_byte(wr * 64 + fr, fq * 8), boff = lds_byte(wc * 32 + fr, fq * 8);
#define PG8_SA(b, h) (((b) * 2 + (h)) * HTB)
#define PG8_SB(b, h) ((4 + (b) * 2 + (h)) * HTB)
#define PG8_STAGE(bufoff, gbase, voff) do { _Pragma("unroll") for (int _i = 0; _i < 2; ++_i) \
        __builtin_amdgcn_global_load_lds((const unsigned*)((const char*)(gbase) + (voff)[_i]), (LAS unsigned*)(lds + (bufoff) + ldsw + _i * 8192), 16, 0, 0); } while (0)
#define PG8_LDA(dst, b, h) do { _Pragma("unroll") for (int m = 0; m < 4; ++m) _Pragma("unroll") for (int k = 0; k < 2; ++k) dst[m][k] = *(const LAS bf16x8*)(lds + PG8_SA(b, h) + aoff + m * 2048 + k * 1024); } while (0)
#define PG8_LDB(dst, b, h) do { _Pragma("unroll") for (int n = 0; n < 2; ++n) _Pragma("unroll") for (int k = 0; k < 2; ++k) dst[n][k] = *(const LAS bf16x8*)(lds + PG8_SB(b, h) + boff + n * 2048 + k * 1024); } while (0)
#define PG8_MMA(ai, bj, At, Bt) do { __builtin_amdgcn_s_setprio(1); _Pragma("unroll") for (int m = 0; m < 4; ++m) _Pragma("unroll") for (int n = 0; n < 2; ++n) _Pragma("unroll") for (int k = 0; k < 2; ++k) \
        acc[ai][bj][m][n] = __builtin_amdgcn_mfma_f32_16x16x32_bf16(Bt[n][k], At[m][k], acc[ai][bj][m][n], 0, 0, 0); __builtin_amdgcn_s_setprio(0); } while (0)
#define PG8_WAIT_V(n) asm volatile("s_waitcnt vmcnt(" #n ")" ::: "memory")
#define PG8_WAIT_L(n) asm volatile("s_waitcnt lgkmcnt(" #n ")" ::: "memory")
#define PG8_BAR __builtin_amdgcn_s_barrier()
#define PG8_SCHED __builtin_amdgcn_sched_barrier(0)
    Unit cur, nxt; int ui = 0;
    if (!S.next(0, cur)) return;
    f32x4 acc[2][2][4][2];
#pragma unroll
    for (int a = 0; a < 2; ++a)
#pragma unroll
        for (int b = 0; b < 2; ++b)
#pragma unroll
            for (int m = 0; m < 4; ++m)
#pragma unroll
                for (int n = 0; n < 2; ++n) acc[a][b][m][n] = (f32x4){0.f, 0.f, 0.f, 0.f};
    bf16x8 At[4][2], B0[2][2], B1[2][2];
    float rsv[8];
#pragma unroll
    for (int i = 0; i < 8; ++i) rsv[i] = 0.f;
    const char* cA = (const char*)g.A + (size_t)cur.pm * tstepA + (size_t)cur.pn * g.a_pn_off; const char* cB = (const char*)g.Bt + (size_t)cur.pn * tstepB;
    PG8_STAGE(PG8_SB(0, 0), cB, voffB); PG8_STAGE(PG8_SA(0, 0), cA, voffA); PG8_STAGE(PG8_SB(0, 1), cB + hstepB, voffB); PG8_STAGE(PG8_SA(0, 1), cA + hstepA, voffA);
    if (wr == 1) PG8_BAR;
    PG8_WAIT_V(4); PG8_BAR;
    PG8_STAGE(PG8_SB(1, 0), cB + kstep, voffB); PG8_STAGE(PG8_SA(1, 0), cA + kstep, voffA); PG8_STAGE(PG8_SB(1, 1), cB + hstepB + kstep, voffB);
    PG8_WAIT_V(6); PG8_BAR;
    for (;;) {
        const bool has_next = S.next(ui + 1, nxt);
        const char* nA = has_next ? (const char*)g.A + (size_t)nxt.pm * tstepA + (size_t)nxt.pn * g.a_pn_off : cA; const char* nB = has_next ? (const char*)g.Bt + (size_t)nxt.pn * tstepB : cB;
        for (int t = 0; t < nt; t += 2) {
            const bool last = (t == nt - 2);
            const char* a1 = cA + (size_t)(t + 1) * kstep;
            const char* a2 = last ? nA : cA + (size_t)(t + 2) * kstep; const char* b2 = last ? nB : cB + (size_t)(t + 2) * kstep;
            const char* a3 = a2 + kstep; const char* b3 = b2 + kstep;
            if (last) E.prefetch(cur, wr, fr, rsv);
            PG8_LDB(B0, 0, 0); PG8_SCHED; PG8_LDA(At, 0, 0); PG8_STAGE(PG8_SA(1, 1), a1 + hstepA, voffA);
            PG8_WAIT_L(8); PG8_BAR; PG8_WAIT_L(0); PG8_MMA(0, 0, At, B0); PG8_BAR; PG8_SCHED;
            PG8_LDB(B1, 0, 1); PG8_STAGE(PG8_SB(0, 0), b2, voffB);
            PG8_BAR; PG8_WAIT_L(0); PG8_MMA(0, 1, At, B1); PG8_BAR;
            PG8_LDA(At, 0, 1); PG8_STAGE(PG8_SA(0, 0), a2, voffA);
            PG8_BAR; PG8_WAIT_L(0); PG8_MMA(1, 0, At, B0); PG8_BAR; PG8_SCHED;
            PG8_STAGE(PG8_SB(0, 1), b2 + hstepB, voffB);
            PG8_WAIT_V(6); PG8_BAR; PG8_MMA(1, 1, At, B1); PG8_BAR;
            PG8_LDB(B0, 1, 0); PG8_SCHED; PG8_LDA(At, 1, 0); PG8_STAGE(PG8_SA(0, 1), a2 + hstepA, voffA);
            PG8_WAIT_L(8); PG8_BAR; PG8_WAIT_L(0); PG8_MMA(0, 0, At, B0); PG8_BAR; PG8_SCHED;
            PG8_LDB(B1, 1, 1); PG8_STAGE(PG8_SB(1, 0), b3, voffB);
            PG8_BAR; PG8_WAIT_L(0); PG8_MMA(0, 1, At, B1); PG8_BAR;
            PG8_LDA(At, 1, 1); PG8_STAGE(PG8_SA(1, 0), a3, voffA);
            PG8_BAR; PG8_WAIT_L(0); PG8_MMA(1, 0, At, B0); PG8_BAR; PG8_SCHED;
            PG8_STAGE(PG8_SB(1, 1), b3 + hstepB, voffB);
            PG8_WAIT_V(6); PG8_BAR; PG8_MMA(1, 1, At, B1); PG8_BAR;
        }
        E(acc, cur, wr, wc, fr, fq, rsv);
        if (!has_next) break;
#pragma unroll
        for (int a = 0; a < 2; ++a)
#pragma unroll
            for (int b = 0; b < 2; ++b)
#pragma unroll
                for (int m = 0; m < 4; ++m)
#pragma unroll
                    for (int n = 0; n < 2; ++n) acc[a][b][m][n] = (f32x4){0.f, 0.f, 0.f, 0.f};
        cur = nxt; cA = nA; cB = nB; ++ui;
    }
    PG8_WAIT_V(0);
    if (wr == 0) PG8_BAR;
    PG8_BAR;
#undef PG8_SA
#undef PG8_SB
#undef PG8_STAGE
#undef PG8_LDA
#undef PG8_LDB
#undef PG8_MMA
#undef PG8_WAIT_V
#undef PG8_WAIT_L
#undef PG8_BAR
#undef PG8_SCHED
}

__device__ __forceinline__ float silu_mul(float g, float u) { return g * __builtin_amdgcn_rcpf(1.0f + __expf(-g)) * u; }

struct EpiSwiGLU {
    const float* ssq; bf16_t* act;
    __device__ __forceinline__ void prefetch(const Unit& u, int wr, int fr, float (&rsv)[8]) const {
#pragma unroll
        for (int ai = 0; ai < 2; ++ai)
#pragma unroll
            for (int m = 0; m < 4; ++m) rsv[ai * 4 + m] = ssq[u.pm * BM + wr * 64 + fr + ai * HALF + m * 16]; }
    __device__ __forceinline__ void operator()(const f32x4 (&acc)[2][2][4][2], const Unit& u, int wr, int wc, int fr, int fq, const float (&rsv)[8]) const {
        const int row0 = u.pm * BM + wr * 64 + fr, col0 = u.pn * 128 + wc * 32 + 8 * fq;
#pragma unroll
        for (int ai = 0; ai < 2; ++ai)
#pragma unroll
            for (int m = 0; m < 4; ++m) {
                const int row = row0 + ai * HALF + m * 16;
                {
                    const float rs = rsqrtf(rsv[ai * 4 + m] * (1.0f / D) + EPS), c1 = rs * -1.4426950408889634f, r2 = rs * rs;
                    u32x4 o;
#pragma unroll
                    for (int n = 0; n < 2; ++n) {
                        const f32x4 ga = acc[ai][0][m][n], ua = acc[ai][1][m][n];
                        const f32x4 t = ga * c1;
                        f32x4 d = {__builtin_amdgcn_exp2f(t[0]), __builtin_amdgcn_exp2f(t[1]), __builtin_amdgcn_exp2f(t[2]), __builtin_amdgcn_exp2f(t[3])};
                        d = d + 1.0f;
                        f32x4 r = {__builtin_amdgcn_rcpf(d[0]), __builtin_amdgcn_rcpf(d[1]), __builtin_amdgcn_rcpf(d[2]), __builtin_amdgcn_rcpf(d[3])};
                        const f32x4 v = (ga * ua) * (r * r2);
                        o[2 * n] = cvt_pk_bf16(v[0], v[1]); o[2 * n + 1] = cvt_pk_bf16(v[2], v[3]);
                    }
                    *(u32x4*)(act + (size_t)row * DFF + col0) = o;
                }
            }
    }
};

template <int MODE> struct EpiRes {
    const float* x; const float* meta; float* out; float* hmeta; bf16_t* hb; float* ssq;
    __device__ __forceinline__ void prefetch(const Unit&, int, int, float (&)[8]) const {}
    __device__ __forceinline__ void operator()(const f32x4 (&acc)[2][2][4][2], const Unit& u, int wr, int wc, int fr, int fq, const float (&rsv)[8]) const {
        const int row0 = u.pm * BM + wr * 64 + fr, col0 = u.pn * BM + wc * 32 + 8 * fq;
        const float fac = (MODE == 6) ? 1.0f : 0.5f;
#pragma unroll
        for (int ai = 0; ai < 2; ++ai) {
            f32x4 r[(MODE == 2) ? 4 : 1][2][2]; u32x4 hr[(MODE == 2) ? 1 : 4][2];
#pragma unroll
            for (int m = 0; m < 4; ++m)
#pragma unroll
                for (int bj = 0; bj < 2; ++bj) { const size_t off = (size_t)(row0 + ai * HALF + m * 16) * D + col0 + bj * HALF;
                    if (MODE == 2) { r[m][bj][0] = *(const f32x4*)(x + off); r[m][bj][1] = *(const f32x4*)(x + off + 4); }
                    else hr[m][bj] = *(const u32x4*)(hb + off); }
#pragma unroll
            for (int m = 0; m < 4; ++m) {
                const int row = row0 + ai * HALF + m * 16;
                float ss = 0.f;
#pragma unroll
                for (int bj = 0; bj < 2; ++bj) {
                    const int c = col0 + bj * HALF;
                    f32x4 r0, r1;
                    if (MODE == 2) { r0 = r[m][bj][0]; r1 = r[m][bj][1]; }
                    else { const u32x4 h = hr[m][bj]; r0 = (f32x4){bf_lo(h[0]), bf_hi(h[0]), bf_lo(h[1]), bf_hi(h[1])}; r1 = (f32x4){bf_lo(h[2]), bf_hi(h[2]), bf_lo(h[3]), bf_hi(h[3])}; }
                    const f32x4 v0 = r0 + acc[ai][bj][m][0] * fac, v1 = r1 + acc[ai][bj][m][1] * fac;
                    if (MODE == 8) { float* orow = out + (size_t)row * D; __builtin_nontemporal_store(v0, (f32x4*)(orow + c)); __builtin_nontemporal_store(v1, (f32x4*)(orow + c + 4)); }
                    else {
                        u32x4 o; o[0] = cvt_pk_bf16(v0[0], v0[1]); o[1] = cvt_pk_bf16(v0[2], v0[3]); o[2] = cvt_pk_bf16(v1[0], v1[1]); o[3] = cvt_pk_bf16(v1[2], v1[3]);
                        *(u32x4*)(hb + (size_t)row * D + c) = o;
                        ss += v0[0] * v0[0] + v0[1] * v0[1] + v0[2] * v0[2] + v0[3] * v0[3] + v1[0] * v1[0] + v1[1] * v1[1] + v1[2] * v1[2] + v1[3] * v1[3];
                    }
                }
                if (MODE != 8) { ss = xsum16_32(ss); if (fq == 0) atomicAdd(ssq + row, ss); }
            }
        }
    }
};

struct EpiZ {
    const float* ssq; bf16_t* z; float* flog; float* ssqqk;
    __device__ __forceinline__ void prefetch(const Unit& u, int wr, int fr, float (&rsv)[8]) const {
#pragma unroll
        for (int ai = 0; ai < 2; ++ai)
#pragma unroll
            for (int m = 0; m < 4; ++m) rsv[ai * 4 + m] = ssq[u.pm * BM + wr * 64 + fr + ai * HALF + m * 16]; }
    __device__ __forceinline__ void operator()(const f32x4 (&acc)[2][2][4][2], const Unit& u, int wr, int wc, int fr, int fq, const float (&rsv)[8]) const {
        const int row0 = u.pm * BM + wr * 64 + fr, col0 = u.pn * BM + wc * 32 + 8 * fq, pn = u.pn;
#pragma unroll
        for (int ai = 0; ai < 2; ++ai)
#pragma unroll
            for (int m = 0; m < 4; ++m) {
                const int row = row0 + ai * HALF + m * 16;
                const bool ok = row < M;
                const float rs = ok ? rsqrtf(rsv[ai * 4 + m] * (1.0f / D) + EPS) : 0.f;
                if (pn < 16) {
#pragma unroll
                    for (int bj = 0; bj < 2; ++bj) {
                        const f32x4 v0 = acc[ai][bj][m][0] * rs, v1 = acc[ai][bj][m][1] * rs;
                        if (ok) { u32x4 o; o[0] = cvt_pk_bf16(v0[0], v0[1]); o[1] = cvt_pk_bf16(v0[2], v0[3]); o[2] = cvt_pk_bf16(v1[0], v1[1]); o[3] = cvt_pk_bf16(v1[2], v1[3]);
                            *(u32x4*)(z + (size_t)row * ZW + col0 + bj * HALF) = o; }
                        if (pn >= 4 && pn < 12) {
                            float ss = v0[0] * v0[0] + v0[1] * v0[1] + v0[2] * v0[2] + v0[3] * v0[3] + v1[0] * v1[0] + v1[1] * v1[1] + v1[2] * v1[2] + v1[3] * v1[3];
                            ss = xsum16_32(ss);
                            if (fq == 0 && ok) ssqqk[(size_t)row * 64 + ((pn - 4) * 2 + bj) * 4 + wc] = ss;
                        }
                    }
                } else if (wc == 0 && fq == 0 && ok) {
                    *(f32x4*)(flog + (size_t)row * 8) = acc[ai][0][m][0] * rs; *(f32x4*)(flog + (size_t)row * 8 + 4) = acc[ai][0][m][1] * rs;
                }
            }
    }
};

struct EpiPlain {
    bf16_t* O;
    __device__ __forceinline__ void prefetch(const Unit&, int, int, float (&)[8]) const {}
    __device__ __forceinline__ void operator()(const f32x4 (&acc)[2][2][4][2], const Unit& u, int wr, int wc, int fr, int fq, const float (&rsv)[8]) const {
        const int row0 = u.pm * BM + wr * 64 + fr, col0 = u.pn * BM + wc * 32 + 8 * fq;
#pragma unroll
        for (int ai = 0; ai < 2; ++ai)
#pragma unroll
            for (int m = 0; m < 4; ++m) {
                const int row = row0 + ai * HALF + m * 16;
                if (row < M) {
#pragma unroll
                    for (int bj = 0; bj < 2; ++bj) {
                        const f32x4 v0 = acc[ai][bj][m][0], v1 = acc[ai][bj][m][1];
                        u32x4 o; o[0] = cvt_pk_bf16(v0[0], v0[1]); o[1] = cvt_pk_bf16(v0[2], v0[3]); o[2] = cvt_pk_bf16(v1[0], v1[1]); o[3] = cvt_pk_bf16(v1[2], v1[3]);
                        *(u32x4*)(O + (size_t)row * D + col0 + bj * HALF) = o;
                    }
                }
            }
    }
};

template <int MODE, int KSTEPS, int UNR>
__device__ __forceinline__ void skinny_phase(const Params& p, unsigned char* shm, int ctr_idx, int ntasks, const int wave_s) {
    unsigned char* ws = p.ws;
    int tid_ = phase_tid(wave_s);
    const int tid = tid_, wid = tid >> 6, lane = tid & 63, fr = lane & 15, quad = lane >> 4;
    f32x4* part = (f32x4*)shm;
    int* taskp = (int*)(shm + 16384);
    int* ctr = (int*)(ws + WS_CTR) + ctr_idx;
    const bf16_t* A = (MODE == 2) ? (const bf16_t*)(ws + WS_ACT) + (size_t)MX * DFF : (const bf16_t*)(ws + WS_HB) + (size_t)MX * D;
    const bf16_t* Bt = (const bf16_t*)(ws + (MODE == 1 ? WS_GU1 : MODE == 2 ? WS_D1 : WS_IN));
    constexpr int LDK = (MODE == 2) ? DFF : D;
    for (;;) {
        __syncthreads();
        if (tid == 0) *taskp = atomicAdd(ctr, 1);
        __syncthreads();
        const int cb = *taskp;
        if (cb >= ntasks) break;
        const int kbase = wid * KSTEPS * 32 + quad * 8;
        const bf16_t* ap = A + (size_t)fr * LDK + kbase;
        const int brow = (MODE == 1) ? ((cb >> 3) * 256 + (cb & 7) * 16 + fr) : cb * 16 + fr;
        const bf16_t* bp = Bt + (size_t)brow * LDK + kbase;
        f32x4 acc0 = {0.f, 0.f, 0.f, 0.f}, acc1 = {0.f, 0.f, 0.f, 0.f};
        for (int s0 = 0; s0 < KSTEPS; s0 += UNR) {
            bf16x8 av[UNR], b0[UNR], b1[UNR];
#pragma unroll
            for (int u = 0; u < UNR; ++u) { av[u] = *(const bf16x8*)(ap + (s0 + u) * 32); b0[u] = *(const bf16x8*)(bp + (s0 + u) * 32);
                if (MODE == 1) b1[u] = *(const bf16x8*)(bp + (size_t)128 * LDK + (s0 + u) * 32); }
#pragma unroll
            for (int u = 0; u < UNR; ++u) { acc0 = __builtin_amdgcn_mfma_f32_16x16x32_bf16(b0[u], av[u], acc0, 0, 0, 0);
                if (MODE == 1) acc1 = __builtin_amdgcn_mfma_f32_16x16x32_bf16(b1[u], av[u], acc1, 0, 0, 0); }
        }
        part[wid * 64 + lane] = acc0;
        if (MODE == 1) part[512 + wid * 64 + lane] = acc1;
        __syncthreads();
        if (wid == 0) {
            f32x4 a0 = part[lane], a1 = {0.f, 0.f, 0.f, 0.f};
#pragma unroll
            for (int w = 1; w < 8; ++w) a0 += part[w * 64 + lane];
            if (MODE == 1) { a1 = part[512 + lane];
#pragma unroll
                for (int w = 1; w < 8; ++w) a1 += part[512 + w * 64 + lane]; }
            const int row = MX + fr, c = cb * 16 + quad * 4;
            if (MODE == 1) {
                const float rs = rsqrtf(((const float*)(ws + WS_SSQ0))[row] * (1.0f / D) + EPS);
                u32x2 o; o[0] = cvt_pk_bf16(silu_mul(a0[0] * rs, a1[0] * rs), silu_mul(a0[1] * rs, a1[1] * rs)); o[1] = cvt_pk_bf16(silu_mul(a0[2] * rs, a1[2] * rs), silu_mul(a0[3] * rs, a1[3] * rs));
                *(u32x2*)((bf16_t*)(ws + WS_ACT) + (size_t)row * DFF + c) = o;
            } else if (MODE == 2) {
                const f32x4 v = *(const f32x4*)(p.in[1] + (size_t)fr * D + c) + a0 * 0.5f;
                *(f32x4*)((float*)(ws + WS_HMETA) + (size_t)fr * D + c) = v;
                u32x2 o; o[0] = cvt_pk_bf16(v[0], v[1]); o[1] = cvt_pk_bf16(v[2], v[3]);
                *(u32x2*)((bf16_t*)(ws + WS_HB) + (size_t)row * D + c) = o;
                float ss = v[0] * v[0] + v[1] * v[1] + v[2] * v[2] + v[3] * v[3];
                ss = xsum16_32(ss);
                if (quad == 0) atomicAdd((float*)(ws + WS_SSQ1) + row, ss);
            } else {
                const float rs = rsqrtf(((const float*)(ws + WS_SSQ1))[row] * (1.0f / D) + EPS);
                const f32x4 v = a0 * rs;
                if (cb < 256) {
                    u32x2 o; o[0] = cvt_pk_bf16(v[0], v[1]); o[1] = cvt_pk_bf16(v[2], v[3]);
                    *(u32x2*)((bf16_t*)(ws + WS_Z) + (size_t)row * ZW + c) = o;
                    if (cb >= 64 && cb < 192) {
                        float ss = v[0] * v[0] + v[1] * v[1] + v[2] * v[2] + v[3] * v[3];
                        ss = xsum16_32(ss);
                        if (quad == 0) atomicAdd((float*)(ws + WS_SSQQK) + (size_t)row * 64 + ((cb - 64) >> 3) * 4, ss);
                    }
                } else if (quad < 2) *(f32x4*)((float*)(ws + WS_FLOG) + (size_t)row * 8 + quad * 4) = v;
            }
        }
    }
}

struct TileDesc { const float* src; const float* gk; const float* sn; bf16_t* dst; int ldn, nvalid, k0, n0, dstK, drow0; };
constexpr int CT_LDB = 288  , CT_SLOT = 128 * CT_LDB;
__device__ __forceinline__ TileDesc cvt_decode(const Params& p, int ti) {
    constexpr int T_FF = 704, T_IN = 16 * 33, T_OUT = 16 * 16;
    unsigned char* ws = p.ws;
    TileDesc d; d.gk = nullptr; d.sn = nullptr;
    if (ti < 6 * T_FF) {
        const int job = ti / T_FF, r = ti - job * T_FF, layer = job / 3, kind = job - layer * 3;
        if (kind < 2) {
            const int tk = r / 44, tn = r - tk * 44;
            d.src = p.in[(layer ? 15 : 3) + kind]; d.dst = (bf16_t*)(ws + (layer ? WS_GU2 : WS_GU1)); d.gk = p.in[layer ? 14 : 2];
            d.ldn = DFF; d.nvalid = DFF; d.k0 = tk * 128; d.n0 = tn * 128; d.dstK = D; d.drow0 = tn * 256 + kind * 128;
        } else {
            const int tk = r / 16, tn = r - tk * 16;
            d.src = p.in[layer ? 17 : 5]; d.dst = (bf16_t*)(ws + (layer ? WS_D2 : WS_D1));
            d.ldn = D; d.nvalid = D; d.k0 = tk * 128; d.n0 = tn * 128; d.dstK = DFF; d.drow0 = tn * 128;
        }
    } else if (ti < 6 * T_FF + T_IN) {
        const int r = ti - 6 * T_FF, tk = r / 33, tn = r - tk * 33;
        d.src = p.in[7]; d.dst = (bf16_t*)(ws + WS_IN); d.gk = p.in[6];
        d.ldn = DIN; d.nvalid = DIN; d.k0 = tk * 128; d.n0 = tn * 128; d.dstK = D; d.drow0 = tn * 128;
    } else if (ti < 6 * T_FF + T_IN + T_OUT) {
        const int r = ti - 6 * T_FF - T_IN, tk = r >> 4, tn = r & 15;
        d.src = p.in[13]; d.dst = (bf16_t*)(ws + WS_OUT);
        d.ldn = D; d.nvalid = D; d.k0 = tk * 128; d.n0 = tn * 128; d.dstK = D; d.drow0 = tn * 128;
    } else {
        const int r = ti - 6 * T_FF - T_IN - T_OUT, g = r >> 2, tk = (r >> 1) & 1, tn = r & 1;
        d.src = p.in[11] + (size_t)g * 65536; d.dst = (bf16_t*)(ws + WS_POOL) + (size_t)g * 65536; d.sn = p.in[12] + g * 256;
        d.ldn = 256; d.nvalid = 256; d.k0 = tk * 128; d.n0 = tn * 128; d.dstK = 256; d.drow0 = tn * 128;
    }
    return d;
}
#define CVT_LOAD(d, v, gv) do { _Pragma("unroll") for (int _i = 0; _i < 8; ++_i) { const int idx = tid + _i * 512, k = idx >> 5, n = (d).n0 + (idx & 31) * 4; \
        v[_i] = (n < (d).nvalid) ? __builtin_nontemporal_load((const f32x4*)((d).src + (size_t)((d).k0 + k) * (d).ldn + n)) : (f32x4){0.f, 0.f, 0.f, 0.f};        \
        gv[_i] = (d).gk ? (d).gk[(d).k0 + k] : 1.0f; } } while (0)
#define CVT_PROCESS(cur, v, gv, MID) do { \
        _Pragma("unroll") for (int i = 0; i < 8; ++i) { const int idx = tid + i * 512, k = idx >> 5, n4 = idx & 31; \
            f32x4 sc = {1.f, 1.f, 1.f, 1.f}; if ((cur).sn) sc = *(const f32x4*)((cur).sn + (cur).n0 + n4 * 4); \
            const float g = gv[i]; u32x2 o; o[0] = cvt_pk_bf16(v[i][0] * g * sc[0], v[i][1] * g * sc[1]); o[1] = cvt_pk_bf16(v[i][2] * g * sc[2], v[i][3] * g * sc[3]); \
            *(u32x2*)(tile + k * CT_LDB + ((n4 * 8) ^ (((k >> 3) & 1) << 7))) = o; } \
        LDS_BARRIER(); \
        MID; \
        { const int w_ = tid >> 6, q_ = (tid >> 4) & 3, i_ = tid & 15; \
          _Pragma("unroll") for (int j = 0; j < 4; ++j) { const int kc = 4 * j + q_, kr = kc * 8 + (i_ >> 2); \
            LAS unsigned char* tp = (LAS unsigned char*)tile + kr * CT_LDB + ((32 * w_ + 8 * (i_ & 3)) ^ ((kc & 1) << 7)); \
            const s16x4 a = __builtin_amdgcn_ds_read_tr16_b64_v4i16((LAS s16x4*)tp), b = __builtin_amdgcn_ds_read_tr16_b64_v4i16((LAS s16x4*)(tp + 4 * CT_LDB)); \
            const bf16x8 o = {a[0], a[1], a[2], a[3], b[0], b[1], b[2], b[3]}; \
            *(bf16x8*)((cur).dst + (size_t)((cur).drow0 + 16 * w_ + i_) * (cur).dstK + (cur).k0 + kc * 8) = o; } } \
        LDS_BARRIER(); } while (0)

__device__ __forceinline__ void prep_phase(const Params& p, unsigned char* shm, const int wave_s) {
    unsigned char* tile = shm;
    unsigned char* ws = p.ws;
    int tid_ = phase_tid(wave_s);
    const int tid = tid_, wid = tid >> 6, lane = tid & 63;
    constexpr int T_ALL = 3 * 704;
    int ti = blockIdx.x;
    TileDesc cur = cvt_decode(p, ti);
    f32x4 v[8]; float gv[8];
    CVT_LOAD(cur, v, gv);
    { float* s1 = (float*)(ws + WS_SSQ1); float* s2 = (float*)(ws + WS_SSQ2); float* sq = (float*)(ws + WS_SSQQK);
      const int gt = blockIdx.x * 512 + tid, nth = gridDim.x * 512;
      for (int i = gt; i < MP; i += nth) { s1[i] = 0.f; s2[i] = 0.f; }
      for (int i = gt; i < (MX + NMETA) * 64; i += nth) sq[i] = 0.f;
      if (gt < 8) ((int*)(ws + WS_CTR))[gt] = 0; }
    { bf16_t* hb = (bf16_t*)(ws + WS_HB); float* ssq0 = (float*)(ws + WS_SSQ0);
      for (int row = blockIdx.x * 8 + wid; row < M; row += gridDim.x * 8) {
          const float* src = (row >= MX) ? p.in[1] + (size_t)(row - MX) * D : p.in[0] + (size_t)row * D;
          float ss = 0.f;
#pragma unroll
          for (int i = 0; i < 8; ++i) { const int c = i * 256 + lane * 4; const f32x4 x4 = *(const f32x4*)(src + c);
              ss += x4[0] * x4[0] + x4[1] * x4[1] + x4[2] * x4[2] + x4[3] * x4[3];
              u32x2 o; o[0] = cvt_pk_bf16(x4[0], x4[1]); o[1] = cvt_pk_bf16(x4[2], x4[3]); *(u32x2*)(hb + (size_t)row * D + c) = o; }
          ss += __shfl_xor(ss, 1); ss += __shfl_xor(ss, 2); ss += __shfl_xor(ss, 4); ss += __shfl_xor(ss, 8); ss += __shfl_xor(ss, 16); ss += __shfl_xor(ss, 32);
          if (lane == 0) ssq0[row] = ss;
      } }
    for (;;) {
        const int tn_ = ti + gridDim.x; const bool has_next = tn_ < T_ALL;
        TileDesc nx = cur; f32x4 vn[8]; float gn[8];
        if (has_next) { nx = cvt_decode(p, tn_); CVT_LOAD(nx, vn, gn); }
        CVT_PROCESS(cur, v, gv, (void)0);
        if (!has_next) break;
        cur = nx; ti = tn_;
#pragma unroll
        for (int i = 0; i < 8; ++i) { v[i] = vn[i]; gv[i] = gn[i]; }
    }
}

template <int WHICH> __device__ __forceinline__ int cvt_qmap(int n) {
    if (WHICH == 0) return n < 800 ? 4224 + n : 2112 + (n - 800);
    return 3520 + n;
}
template <int WHICH> __device__ __forceinline__ void cvt_queue(const Params& p, unsigned char* shm, int ctr_idx, int count, const int wave_s) {
    unsigned char* tile = shm;
    volatile int* slot = (volatile int*)(shm + CT_SLOT);
    int* ctr = (int*)(p.ws + WS_CTR) + ctr_idx;
    int tid_ = phase_tid(wave_s);
    const int tid = tid_;
    __syncthreads();
    if (tid == 0) { slot[0] = atomicAdd(ctr, 1); slot[1] = atomicAdd(ctr, 1); }
    __syncthreads();
    int n_cur = slot[0], n_nxt = slot[1];
    if (n_cur >= count) return;
    TileDesc cur = cvt_decode(p, cvt_qmap<WHICH>(n_cur));
    f32x4 v[8]; float gv[8];
    CVT_LOAD(cur, v, gv);
    for (;;) {
        const bool has_next = n_nxt < count;
        TileDesc nx = cur; f32x4 vn[8]; float gn[8];
        if (has_next) { nx = cvt_decode(p, cvt_qmap<WHICH>(n_nxt)); CVT_LOAD(nx, vn, gn); }
        if (tid == 0) slot[2] = atomicAdd(ctr, 1);
        int n_after = 0;
        CVT_PROCESS(cur, v, gv, n_after = slot[2]);
        if (!has_next) break;
        cur = nx; n_nxt = n_after;
#pragma unroll
        for (int i = 0; i < 8; ++i) { v[i] = vn[i]; gv[i] = gn[i]; }
    }
}

__device__ __forceinline__ void flog_phase(const Params& p, unsigned char* shm, const int wave_s) {
    unsigned char* ws = p.ws;
    int tid_ = phase_tid(wave_s);
    const int tid = tid_, wid = tid >> 6, lane = tid & 63, fr = lane & 15, quad = lane >> 4;
    f32x4* part = (f32x4*)shm;
    for (int t2 = blockIdx.x; t2 < 256; t2 += gridDim.x) {
        const int task = t2 * 2 + (wid >> 2), kq = wid & 3;
        const bf16_t* hp = (const bf16_t*)(ws + WS_HB) + (size_t)(task * 16 + fr) * D + kq * 512 + quad * 8;
        const bf16_t* wp = (const bf16_t*)(ws + WS_IN) + (size_t)(4096 + fr) * D + kq * 512 + quad * 8;
        f32x4 acc = {0.f, 0.f, 0.f, 0.f};
#pragma unroll
        for (int s0 = 0; s0 < 16; s0 += 8) {
            bf16x8 hv[8], wv[8];
#pragma unroll
            for (int u = 0; u < 8; ++u) { hv[u] = *(const bf16x8*)(hp + (s0 + u) * 32); wv[u] = *(const bf16x8*)(wp + (s0 + u) * 32); }
#pragma unroll
            for (int u = 0; u < 8; ++u) acc = __builtin_amdgcn_mfma_f32_16x16x32_bf16(wv[u], hv[u], acc, 0, 0, 0);
        }
        __syncthreads();
        part[wid * 64 + lane] = acc;
        __syncthreads();
        if ((wid & 3) == 0) {
            const f32x4 a = part[wid * 64 + lane] + part[(wid + 1) * 64 + lane] + part[(wid + 2) * 64 + lane] + part[(wid + 3) * 64 + lane];
            const int row = task * 16 + fr;
            const float rs = rsqrtf(((const float*)(ws + WS_SSQ1))[row] * (1.0f / D) + EPS);
            if (quad < 2) *(f32x4*)((float*)(ws + WS_FLOG) + (size_t)row * 8 + quad * 4) = a * rs;
        }
    }
}

__device__ __forceinline__ float log_sigmoid(float v) { return fminf(v, 0.f) - log1pf(expf(-fabsf(v))); }
template <int W> __device__ __forceinline__ void pooled_item(const bf16_t* __restrict__ z, bf16_t* __restrict__ pb  , int b, int t0  , int c0) {
    u32x4 r[W + 7];
#pragma unroll
    for (int i = 0; i < W + 7; ++i) { const int t = t0 - (W - 1) + i; r[i] = (t >= 0) ? *(const u32x4*)(z + (size_t)grow_of(b, t) * ZW + c0) : (u32x4){0u, 0u, 0u, 0u}; }
    float a[8] = {0.f, 0.f, 0.f, 0.f, 0.f, 0.f, 0.f, 0.f};
#pragma unroll
    for (int i = 0; i < W - 1; ++i)
#pragma unroll
        for (int e = 0; e < 4; ++e) { a[2 * e] += bf_lo(r[i][e]); a[2 * e + 1] += bf_hi(r[i][e]); }
#pragma unroll
    for (int i = 0; i < 8; ++i) {
        const u32x4 cur = r[W - 1 + i];
#pragma unroll
        for (int e = 0; e < 4; ++e) { a[2 * e] += bf_lo(cur[e]); a[2 * e + 1] += bf_hi(cur[e]); }
        const int t = t0 + i, cnt = (t + 1 < W) ? t + 1 : W;
        const float inv = 1.0f / (float)cnt;
        u32x4 o;
#pragma unroll
        for (int e = 0; e < 4; ++e) o[e] = cvt_pk_bf16(a[2 * e] * inv - bf_lo(cur[e]), a[2 * e + 1] * inv - bf_hi(cur[e]));
        *(u32x4*)(pb + (size_t)(t - NMETA) * 1024 + c0) = o;
#pragma unroll
        for (int e = 0; e < 4; ++e) { a[2 * e] -= bf_lo(r[i][e]); a[2 * e + 1] -= bf_hi(r[i][e]); }
    }
}
__device__ __forceinline__ void mid_phase(const Params& p, unsigned char* shm, const int wave_s) {
    unsigned char* ws = p.ws;
    int tid_ = phase_tid(wave_s);
    const int tid = tid_, lane = tid & 63, wid = tid >> 6;
    const bf16_t* z = (const bf16_t*)(ws + WS_Z);
    if (blockIdx.x < 32) {
        const int bh = blockIdx.x, b = bh >> 3, h = bh & 7;
        const float* flog = (const float*)(ws + WS_FLOG); float* cum = (float*)(ws + WS_CUM);
        float* wtot = (float*)shm;
        const float bf = p.in[8][h];
        const int t0 = tid * 5;
        float lf[5]; float tot = 0.f;
#pragma unroll
        for (int i = 0; i < 5; ++i) { const int t = t0 + i; lf[i] = (t < L) ? log_sigmoid(flog[(size_t)grow_of(b, t) * 8 + h] + bf) : 0.f; tot += lf[i]; }
        float inc = tot;
#pragma unroll
        for (int o = 1; o < 64; o <<= 1) { const float y = __shfl_up(inc, o); if (lane >= o) inc += y; }
        if (lane == 63) wtot[wid] = inc;
        __syncthreads();
        float run = inc - tot;
        for (int w = 0; w < wid; ++w) run += wtot[w];
#pragma unroll
        for (int i = 0; i < 5; ++i) { const int t = t0 + i; run += lf[i]; if (t < L) cum[bh * CUML + t] = run; }
    }
    if (blockIdx.x < 32) {
        __syncthreads();
        if (tid == 0) { __builtin_amdgcn_fence(__ATOMIC_RELEASE, "agent"); asm volatile("s_waitcnt vmcnt(0)" ::: "memory");
            __hip_atomic_fetch_add((int*)(ws + WS_CTR) + 7, 1, __ATOMIC_RELAXED, __HIP_MEMORY_SCOPE_AGENT); }
    }
}
__device__ __forceinline__ void pooled_for_unit(const Params& p, const int upm, const int upn, const int wave_s) {
    unsigned char* ws = p.ws;
    const int tid = phase_tid(wave_s);
    const bf16_t* z = (const bf16_t*)(ws + WS_Z); bf16_t* pooled = (bf16_t*)(ws + WS_POOLED);
    const int b = upm >> 3, g = upn;
    bf16_t* pb = pooled + (size_t)b * SEQ * 1024;
#pragma unroll
    for (int i = 0; i < 2; ++i) { const int idx = tid + i * 512, rc = idx >> 5, cc = idx & 31;
        const int t0 = NMETA + (upm & 7) * 256 + rc * 8, c0 = g * 256 + cc * 8;
        if (g == 0) pooled_item<2>(z, pb, b, t0, c0); else if (g == 1) pooled_item<4>(z, pb, b, t0, c0); else if (g == 2) pooled_item<8>(z, pb, b, t0, c0); else pooled_item<16>(z, pb, b, t0, c0); }
}

constexpr int V_LDB = 288  ;
constexpr int KS_LD = 144  , VT_LD = 72, AT_VT = 64 * KS_LD * 2, AT_KSC = AT_VT + 128 * VT_LD * 2, AT_KCM = AT_KSC + 256, AT_BUF = AT_KCM + 256  , AT_ITEM = 2 * AT_BUF;
constexpr int N_ITEMS = 32 * 16;
__device__ __forceinline__ void attn_phase(const Params& p, unsigned char* shm, int ctr_idx, const int wave_s) {
    unsigned char* ws = p.ws;
    int tid_ = phase_tid(wave_s);
    const int tid = tid_, wid = tid >> 6, lane = tid & 63, fr = lane & 15, quad = lane >> 4;
    int* itemp = (int*)(shm + AT_ITEM);
    const bf16_t* z = (const bf16_t*)(ws + WS_Z); const float* ssqqk = (const float*)(ws + WS_SSQQK); const float* cum = (const float*)(ws + WS_CUM);
    bf16_t* mix = (bf16_t*)(ws + WS_MIX); int* ctr = (int*)(ws + WS_CTR) + ctr_idx;
    const float* gq = p.in[9]; const float* gkn = p.in[10];
    const float LOG2E = 1.4426950408889634f;
    for (;;) {
        __syncthreads();
        if (tid == 0) *itemp = atomicAdd(ctr, 1);
        __syncthreads();
        const int item = *itemp;
        if (item >= N_ITEMS) break;
        const int j = 16 - item / 32, bh = item & 31, b = bh >> 3, h = bh & 7;
        const int rowbase = 16 + 128 * (j - 1), ntiles = 2 * j + 1;
        const bool wvalid = true;
        const int qr0 = rowbase + 16 * wid;
        const int qrow = qr0 + fr; const size_t grow = (size_t)b * SEQ + (qrow - NMETA);
        const f32x4 qss = *(const f32x4*)(ssqqk + grow * 64 + h * 4);
        const float qs = rsqrtf((qss[0] + qss[1] + qss[2] + qss[3]) * (1.0f / DHD) + EPS) * 0.08838834764831845f;
        bf16x8 qf[4]; float gmax = 0.f;
#pragma unroll
        for (int ks = 0; ks < 4; ++ks) { const int d0 = ks * 32 + quad * 8;
            const u32x4 raw = *(const u32x4*)(z + grow * ZW + 1024 + h * DHD + d0);
            const f32x4 a0 = *(const f32x4*)(gq + d0), a1 = *(const f32x4*)(gq + d0 + 4), b0 = *(const f32x4*)(gkn + d0), b1 = *(const f32x4*)(gkn + d0 + 4);
            u32x4 o;
            o[0] = cvt_pk_bf16(bf_lo(raw[0]) * a0[0] * b0[0] * qs, bf_hi(raw[0]) * a0[1] * b0[1] * qs); o[1] = cvt_pk_bf16(bf_lo(raw[1]) * a0[2] * b0[2] * qs, bf_hi(raw[1]) * a0[3] * b0[3] * qs);
            o[2] = cvt_pk_bf16(bf_lo(raw[2]) * a1[0] * b1[0] * qs, bf_hi(raw[2]) * a1[1] * b1[1] * qs); o[3] = cvt_pk_bf16(bf_lo(raw[3]) * a1[2] * b1[2] * qs, bf_hi(raw[3]) * a1[3] * b1[3] * qs);
#pragma unroll
            for (int e = 0; e < 4; ++e) gmax = fmaxf(gmax, fmaxf(fabsf(a0[e] * b0[e]), fabsf(a1[e] * b1[e])));
            qf[ks] = __builtin_bit_cast(bf16x8, o); }
        gmax = fmaxf(gmax, __shfl_xor(gmax, 16)); gmax = fmaxf(gmax, __shfl_xor(gmax, 32));
        const float Coff = gmax * (128.0f * 0.08838834764831845f);
        const float cumq = (cum[bh * CUML + qrow] - Coff) * LOG2E;
        const int vlane = (8 * quad + (fr >> 2)) * V_LDB + ((fr & 3) >> 1) * 16 + 8 * (fr & 1);
        f32x4 O[8];
#pragma unroll
        for (int i = 0; i < 8; ++i) O[i] = (f32x4){0.f, 0.f, 0.f, 0.f};
        float lsum = 0.f;
        u32x4 kreg0[2], vreg0[2], kreg1[2], vreg1[2]; f32x4 kss_r0 = {0.f, 0.f, 0.f, 0.f}, kss_r1 = {0.f, 0.f, 0.f, 0.f}; float kcm_r0 = 0.f, kcm_r1 = 0.f;
#define AT_PREFETCH(kt, R) do { _Pragma("unroll") for (int _i = 0; _i < 2; ++_i) { const int idx = tid + _i * 512, key = idx >> 4, ch = idx & 15; int gkey = (kt) * 64 + key; gkey = gkey < L ? gkey : L - 1; \
            const bf16_t* rp = z + (size_t)grow_of(b, gkey) * ZW + h * DHD + ch * 8; kreg##R[_i] = *(const u32x4*)(rp + 2048); vreg##R[_i] = *(const u32x4*)(rp + 3072); } \
            if (tid < 64) { int gkey = (kt) * 64 + tid; gkey = gkey < L ? gkey : L - 1; kss_r##R = *(const f32x4*)(ssqqk + (size_t)grow_of(b, gkey) * 64 + (8 + h) * 4); kcm_r##R = cum[bh * CUML + gkey]; } } while (0)
#define AT_WRITE(bufp, R) do { bf16_t* Ks_ = (bf16_t*)(bufp); unsigned char* Vb_ = (bufp) + AT_VT; \
            _Pragma("unroll") for (int i = 0; i < 2; ++i) { const int idx = tid + i * 512, key = idx >> 4, ch = idx & 15; \
                const int rho = (key & 32) + ((key >> 2) & 1) * 16 + ((key & 31) >> 3) * 4 + (key & 3); \
                *(u32x4*)(Ks_ + rho * KS_LD + ch * 8) = kreg##R[i]; \
                *(u32x4*)(Vb_ + key * V_LDB + ((ch ^ (((key >> 3) & 1) << 3)) << 4)) = vreg##R[i]; } \
            if (tid < 64) { ((float*)((bufp) + AT_KSC))[tid] = rsqrtf((kss_r##R[0] + kss_r##R[1] + kss_r##R[2] + kss_r##R[3]) * (1.0f / DHD) + EPS) * LOG2E; ((float*)((bufp) + AT_KCM))[tid] = kcm_r##R * LOG2E; } } while (0)
        auto tile_compute = [&](const int kt) __attribute__((always_inline)) {
            unsigned char* bufc = shm + (kt & 1) * AT_BUF;
            const bf16_t* Ks = (const bf16_t*)bufc;
            LAS unsigned char* vA = (LAS unsigned char*)(bufc + AT_VT) + vlane + (quad & 1) * 128; LAS unsigned char* vB = (LAS unsigned char*)(bufc + AT_VT) + vlane - (quad & 1) * 128;
            const float* kscl = (const float*)(bufc + AT_KSC); const float* kcm = (const float*)(bufc + AT_KCM);
            if (kt * 64 <= qr0 + 15) {
                f32x4 S[4];
#pragma unroll
                for (int blk = 0; blk < 4; ++blk) { S[blk] = (f32x4){0.f, 0.f, 0.f, 0.f};
#pragma unroll
                    for (int ks = 0; ks < 4; ++ks) { const bf16x8 kf = *(const bf16x8*)(Ks + (blk * 16 + fr) * KS_LD + ks * 32 + quad * 8);
                        S[blk] = __builtin_amdgcn_mfma_f32_16x16x32_bf16(kf, qf[ks], S[blk], 0, 0, 0); } }
                const bool need_mask = (kt * 64 + 63 > qr0);
                const f32x4 cq4 = {cumq, cumq, cumq, cumq};
#pragma unroll
                for (int blk = 0; blk < 4; ++blk) { const int kb = (blk >> 1) * 32 + quad * 8 + (blk & 1) * 4;
                    const f32x4 sc = *(const f32x4*)(kscl + kb), cm = *(const f32x4*)(kcm + kb);
                    S[blk] = S[blk] * sc + (cq4 - cm); }
                if (need_mask) {
#pragma unroll
                    for (int blk = 0; blk < 4; ++blk) { const int kb = (blk >> 1) * 32 + quad * 8 + (blk & 1) * 4;
#pragma unroll
                        for (int i = 0; i < 4; ++i) if (kt * 64 + kb + i > qrow) S[blk][i] = -1e30f; } }
#pragma unroll
                for (int blk = 0; blk < 4; ++blk)
#pragma unroll
                    for (int i = 0; i < 4; ++i) S[blk][i] = __builtin_amdgcn_exp2f(S[blk][i]);
                { const f32x4 s4 = (S[0] + S[1]) + (S[2] + S[3]); lsum += (s4[0] + s4[1]) + (s4[2] + s4[3]); }
                bf16x8 pf[2];
#pragma unroll
                for (int G = 0; G < 2; ++G) { u32x4 o; o[0] = cvt_pk_bf16(S[2 * G][0], S[2 * G][1]); o[1] = cvt_pk_bf16(S[2 * G][2], S[2 * G][3]);
                    o[2] = cvt_pk_bf16(S[2 * G + 1][0], S[2 * G + 1][1]); o[3] = cvt_pk_bf16(S[2 * G + 1][2], S[2 * G + 1][3]); pf[G] = __builtin_bit_cast(bf16x8, o); }
#pragma unroll
                for (int db = 0; db < 8; ++db)
#pragma unroll
                    for (int G = 0; G < 2; ++G) { LAS unsigned char* vp = (db < 4 ? vA : vB) + (32 * G) * V_LDB + 32 * db;
                        const s16x4 v0 = __builtin_amdgcn_ds_read_tr16_b64_v4i16((LAS s16x4*)vp), v1 = __builtin_amdgcn_ds_read_tr16_b64_v4i16((LAS s16x4*)(vp + 4 * V_LDB));
                        const bf16x8 vf = {v0[0], v0[1], v0[2], v0[3], v1[0], v1[1], v1[2], v1[3]};
                        O[db] = __builtin_amdgcn_mfma_f32_16x16x32_bf16(vf, pf[G], O[db], 0, 0, 0); }
            }
        };
        AT_PREFETCH(0, 0);
        AT_WRITE(shm, 0);
        AT_PREFETCH(1, 1);
        AT_PREFETCH(2, 0);
        LDS_BARRIER();
        for (int kt = 0; kt < ntiles; kt += 2) {
            if (kt + 1 < ntiles) AT_WRITE(shm + AT_BUF, 1);
            if (kt + 3 < ntiles) AT_PREFETCH(kt + 3, 1);
            tile_compute(kt);
            LDS_BARRIER();
            if (kt + 1 < ntiles) {
                if (kt + 2 < ntiles) AT_WRITE(shm, 0);
                if (kt + 4 < ntiles) AT_PREFETCH(kt + 4, 0);
                tile_compute(kt + 1);
                LDS_BARRIER();
            }
        }
#undef AT_PREFETCH
#undef AT_WRITE
        lsum = xsum16_32(lsum);
        const float inv = 1.0f / lsum;
        if (wvalid) {
#pragma unroll
            for (int db = 0; db < 8; ++db) { u32x2 o; o[0] = cvt_pk_bf16(O[db][0] * inv, O[db][1] * inv); o[1] = cvt_pk_bf16(O[db][2] * inv, O[db][3] * inv);
                *(u32x2*)(mix + grow * D + 1024 + h * DHD + db * 16 + quad * 4) = o; }
        }
    }
}

constexpr int LDS_BYTES = STAGE_BYTES + 16;
__global__ __launch_bounds__(512, 2) void hymba_fwd(Params p) {
    extern __shared__ __attribute__((aligned(16))) unsigned char shm[];
    LAS unsigned char* lds = (LAS unsigned char*)shm;
    cg::grid_group grid = cg::this_grid();
    unsigned char* ws = p.ws;
    bf16_t* hb = (bf16_t*)(ws + WS_HB); bf16_t* act = (bf16_t*)(ws + WS_ACT); bf16_t* z = (bf16_t*)(ws + WS_Z); bf16_t* mix = (bf16_t*)(ws + WS_MIX);
    float* hmeta = (float*)(ws + WS_HMETA);
    float* ssq0 = (float*)(ws + WS_SSQ0); float* ssq1 = (float*)(ws + WS_SSQ1); float* ssq2 = (float*)(ws + WS_SSQ2);
    const int G = gridDim.x, c = blockIdx.x;
    const int wave_s = __builtin_amdgcn_readfirstlane((int)threadIdx.x >> 6);
    StaticOrder S;
    if (phase_tid(wave_s) == 0) { *(volatile LAS unsigned*)(lds + STAGE_BYTES) = 0u; *(volatile LAS unsigned*)(lds + STAGE_BYTES + 4) = 0u; }
    __syncthreads();
    const XcdBarrier xb = xcd_barrier_post((unsigned*)(ws + WS_BAR), (volatile LAS unsigned*)(lds + STAGE_BYTES), wave_s);

    prep_phase(p, shm, wave_s);
    if (p.ws == nullptr) grid.sync();
    xcd_barrier(xb, wave_s);
    { Gemm g{hb, (const bf16_t*)(ws + WS_GU1), D, D, D, 0}; S.init(32, 44, G, c); EpiSwiGLU E{ssq0, act}; gemm_phase(lds, g, S, E, wave_s);
    }
    skinny_phase<1, 8, 8>(p, shm, 1, 352, wave_s);
    cvt_queue<0>(p, shm, 4, 800 + 1408, wave_s);
    xcd_barrier(xb, wave_s);
    { Gemm g{act, (const bf16_t*)(ws + WS_D1), DFF, DFF, DFF, 0}; S.init(32, 8, G, c); EpiRes<2> E{p.in[0], p.in[1], p.out, hmeta, hb, ssq1}; gemm_phase(lds, g, S, E, wave_s); }
    skinny_phase<2, 22, 11>(p, shm, 2, 128, wave_s);
    xcd_barrier(xb, wave_s);
    { Gemm g{hb, (const bf16_t*)(ws + WS_IN), D, D, D, 0}; S.init(32, 16, G, c); EpiZ E{ssq1, z, (float*)(ws + WS_FLOG), (float*)(ws + WS_SSQQK)}; gemm_phase(lds, g, S, E, wave_s); }
    skinny_phase<3, 8, 8>(p, shm, 3, 257, wave_s);
    flog_phase(p, shm, wave_s);
    xcd_barrier(xb, wave_s);
    mid_phase(p, shm, wave_s);
    { Gemm g{(const bf16_t*)(ws + WS_POOLED), (const bf16_t*)(ws + WS_POOL), 1024, 256, 256, 512}; S.init(32, 4, G, c); EpiPlain E{mix};
      for (int i = 0;; ++i) { Unit u; if (!S.next(i, u)) break; pooled_for_unit(p, u.pm, u.pn, wave_s); }
      asm volatile("s_waitcnt vmcnt(0)" ::: "memory"); __syncthreads();
      gemm_phase(lds, g, S, E, wave_s); }
    { if (phase_tid(wave_s) == 0) { int* flag = (int*)(ws + WS_CTR) + 7; unsigned sp = 0;
          while (__hip_atomic_load(flag, __ATOMIC_RELAXED, __HIP_MEMORY_SCOPE_AGENT) < 32) { __builtin_amdgcn_s_sleep(1); if (++sp > (1u << 22)) break; }
          __builtin_amdgcn_fence(__ATOMIC_ACQUIRE, "agent"); asm volatile("s_waitcnt vmcnt(0)" ::: "memory"); }
      __syncthreads(); }
    attn_phase(p, shm, 0, wave_s);
    xcd_barrier(xb, wave_s);
    { Gemm g{mix, (const bf16_t*)(ws + WS_OUT), D, D, D, 0}; S.init(32, 8, G, c); EpiRes<6> E{p.in[0], p.in[1], p.out, hmeta, hb, ssq2}; gemm_phase(lds, g, S, E, wave_s); }
    xcd_barrier(xb, wave_s);
    { Gemm g{hb, (const bf16_t*)(ws + WS_GU2), D, D, D, 0}; S.init(32, 44, G, c); EpiSwiGLU E{ssq2, act}; gemm_phase(lds, g, S, E, wave_s); }
    cvt_queue<1>(p, shm, 5, 704, wave_s);
    xcd_barrier(xb, wave_s);
    { Gemm g{act, (const bf16_t*)(ws + WS_D2), DFF, DFF, DFF, 0}; S.init(32, 8, G, c); EpiRes<8> E{p.in[0], p.in[1], p.out, hmeta, hb, ssq2}; gemm_phase(lds, g, S, E, wave_s); }
}

extern "C" void kernel_launch(void* const* d_in, const int* in_sizes, int n_in, void* d_out, int out_size, void* d_ws, size_t ws_size, hipStream_t stream) {
    static int grid_blocks = 0;
    if (grid_blocks == 0) {
        if (n_in != 18 || ws_size < WS_END) { fprintf(stderr, "kernel_launch: need 18 inputs and %zu bytes of workspace (got %d, %zu)\n", (size_t)WS_END, n_in, ws_size); grid_blocks = -1; return; }
        int dev = 0, cus = 0, per_cu = 0;
        (void)hipGetDevice(&dev);
        (void)hipDeviceGetAttribute(&cus, hipDeviceAttributeMultiprocessorCount, dev);
        (void)hipFuncSetAttribute((const void*)hymba_fwd, hipFuncAttributeMaxDynamicSharedMemorySize, LDS_BYTES);
        (void)hipOccupancyMaxActiveBlocksPerMultiprocessor(&per_cu, (const void*)hymba_fwd, 512, LDS_BYTES);
        if (per_cu < 1) per_cu = 1;
        grid_blocks = cus * per_cu;
    }
    if (grid_blocks < 0) return;
    if (hipMemsetAsync((char*)d_ws + WS_BAR, 0, XCD_BAR_WORDS * 4, stream) != hipSuccess) { fprintf(stderr, "memset failed\n"); return; }
    Params p{};
    for (int i = 0; i < 18; ++i) p.in[i] = (const float*)d_in[i];
    p.out = (float*)d_out; p.ws = (unsigned char*)d_ws;
    void* args[] = {&p};
    hipError_t e = hipLaunchCooperativeKernel((const void*)hymba_fwd, dim3(grid_blocks), dim3(512), args, LDS_BYTES, stream);
    if (e != hipSuccess) fprintf(stderr, "cooperative launch failed: %s (grid %d)\n", hipGetErrorString(e), grid_blocks);
}
```

```cpp
#include <hip/hip_runtime.h>
#include <hip/hip_cooperative_groups.h>
#include <cstdio>
namespace cg = cooperative_groups;

#define LAS __attribute__((address_space(3)))
typedef unsigned short bf16_t;
typedef short bf16x8 __attribute__((ext_vector_type(8)));
typedef float f32x4 __attribute__((ext_vector_type(4)));
typedef unsigned u32x4 __attribute__((ext_vector_type(4)));
typedef unsigned u32x2 __attribute__((ext_vector_type(2)));
typedef short s16x4 __attribute__((ext_vector_type(4)));

constexpr int D = 2048, NB = 4, SEQ = 2048, NMETA = 16, L = NMETA + SEQ  , MX = NB * SEQ  , M = MX + NMETA  , MP = 8448;
constexpr int DFF = 5632, DIN = 4104, NH = 8, DHD = 128, ZW = 4096  , CUML = 2112;
constexpr float EPS = 1e-6f;

constexpr size_t al256(size_t x) { return (x + 255) & ~(size_t)255; }
constexpr size_t WS_GU1 = 0;
constexpr size_t WS_D1 = WS_GU1 + (size_t)2 * DFF * D * 2;
constexpr size_t WS_IN = WS_D1 + (size_t)D * DFF * 2;
constexpr size_t WS_OUT = WS_IN + (size_t)4352 * D * 2;
constexpr size_t WS_POOL = WS_OUT + (size_t)D * D * 2;
constexpr size_t WS_GU2 = WS_POOL + (size_t)1024 * 256 * 2;
constexpr size_t WS_D2 = WS_GU2 + (size_t)2 * DFF * D * 2;
constexpr size_t WS_HB = WS_D2 + (size_t)D * DFF * 2;
constexpr size_t WS_ACT = WS_HB + (size_t)MP * D * 2;
constexpr size_t WS_Z = WS_ACT;
constexpr size_t WS_POOLED = WS_Z + (size_t)MP * ZW * 2;
constexpr size_t WS_MIX = WS_ACT + (size_t)MP * DFF * 2;
constexpr size_t WS_HMETA = WS_MIX + (size_t)MP * D * 2;
constexpr size_t WS_FLOG = WS_HMETA + (size_t)NMETA * D * 4;
constexpr size_t WS_CUM = WS_FLOG + (size_t)MP * 8 * 4;
constexpr size_t WS_SSQ0 = WS_CUM + (size_t)32 * CUML * 4;
constexpr size_t WS_SSQ1 = WS_SSQ0 + (size_t)MP * 4;
constexpr size_t WS_SSQ2 = WS_SSQ1 + (size_t)MP * 4;
constexpr size_t WS_SSQQK = WS_SSQ2 + (size_t)MP * 4;
constexpr size_t WS_CTR = WS_SSQQK + (size_t)MP * 64 * 4;
constexpr size_t WS_BAR = WS_CTR + 256;
constexpr size_t WS_END = WS_BAR + 3456 * 4;
static_assert(WS_POOLED + (size_t)MP * 1024 * 2 <= WS_MIX, "z + pooled must fit in the act region");

struct Params { const float* in[18]; float* out; unsigned char* ws; };

__device__ __forceinline__ unsigned cvt_pk_bf16(float lo, float hi) { unsigned r; asm volatile("v_cvt_pk_bf16_f32 %0, %1, %2" : "=v"(r) : "v"(lo), "v"(hi)); return r; }
#define LDS_BARRIER() do { asm volatile("s_waitcnt lgkmcnt(0)" ::: "memory"); __builtin_amdgcn_s_barrier(); asm volatile("" ::: "memory"); } while (0)
__device__ __forceinline__ int phase_tid(int wave_s) { int lane; asm volatile("v_mbcnt_lo_u32_b32 %0, -1, 0\n\tv_mbcnt_hi_u32_b32 %0, -1, %0" : "=v"(lane)); return wave_s * 64 + lane; }
__device__ __forceinline__ float bf_lo(unsigned u) { return __uint_as_float(u << 16); }
__device__ __forceinline__ float bf_hi(unsigned u) { return __uint_as_float(u & 0xffff0000u); }
__device__ __forceinline__ int grow_of(int b, int pos) { return pos < NMETA ? MX + pos : b * SEQ + pos - NMETA; }
__device__ __forceinline__ float xsum16_32(float v) { v += __shfl_xor(v, 16); v += __shfl_xor(v, 32); return v; }


#define XB_TMO      128
#define XB_XCNT(j)  (256  + 64 * (j))
#define XB_XSUB(j)  (1280 + 64 * (j))
#define XB_XGEN(j)  (2304 + 64 * (j))
#define XB_TOP      3328
#define XB_TOPGEN   3392
#define XCD_BAR_WORDS 3456
#define XB_SPIN_CAP (1u << 18)
__device__ __forceinline__ unsigned xb_ld(unsigned* p)              { return __hip_atomic_load(p, __ATOMIC_RELAXED, __HIP_MEMORY_SCOPE_AGENT); }
__device__ __forceinline__ unsigned xb_add(unsigned* p, unsigned v) { return __hip_atomic_fetch_add(p, v, __ATOMIC_RELAXED, __HIP_MEMORY_SCOPE_AGENT); }
__device__ __forceinline__ unsigned xb_xcc_id() { return (unsigned)__builtin_amdgcn_s_getreg((3 << 11) | 20) & 0xFu; }
#define XB_SPIN(cond, bar) do { unsigned _sp = 0; while (cond) { __builtin_amdgcn_s_sleep(1); \
    if ((++_sp & 255u) == 0u) { if (xb_ld(&(bar)[XB_TMO])) break; if (_sp > XB_SPIN_CAP) { atomicAdd(&(bar)[XB_TMO], 1u); break; } } } } while (0)
struct XcdBarrier { unsigned* bar; unsigned x; volatile LAS unsigned* st; };
__device__ __forceinline__ XcdBarrier xcd_barrier_post(unsigned* bar, volatile LAS unsigned* st, const int wave_s) {
    XcdBarrier b; b.bar = bar; b.x = xb_xcc_id(); b.st = st;
    if (phase_tid(wave_s) == 0) (void)xb_add(&bar[XB_XCNT(b.x)], 1u);
    return b;
}
__device__ __forceinline__ void xcd_barrier_complete(unsigned* bar, unsigned x, unsigned& nloc, unsigned& nx) {
    const unsigned G = gridDim.x * gridDim.y * gridDim.z;
    unsigned sum, cnt, mine, sp = 0u;
    for (;;) {
        sum = 0u; cnt = 0u; mine = 0u;
#pragma unroll
        for (unsigned j = 0; j < 16; ++j) { const unsigned c = xb_ld(&bar[XB_XCNT(j)]); sum += c; cnt += (c > 0u) ? 1u : 0u; mine = (j == x) ? c : mine; }
        if (sum == G) break;
        __builtin_amdgcn_s_sleep(1);
        if ((++sp & 255u) == 0u) { if (xb_ld(&bar[XB_TMO])) break; if (sp > XB_SPIN_CAP) { atomicAdd(&bar[XB_TMO], 1u); break; } }
    }
    nloc = mine > 0u ? mine : 1u; nx = cnt > 0u ? cnt : 1u;
}
__device__ __forceinline__ void xcd_barrier(const XcdBarrier& b, const int wave_s) {
    asm volatile("s_waitcnt vmcnt(0)" ::: "memory");
    __syncthreads();
    if (phase_tid(wave_s) == 0) {
        unsigned* bar = b.bar;
        __builtin_amdgcn_s_waitcnt(0);
        unsigned nloc = b.st[0], nx = b.st[1];
        if (nloc == 0u) { xcd_barrier_complete(bar, b.x, nloc, nx); b.st[0] = nloc; b.st[1] = nx; }
        const unsigned old = xb_add(&bar[XB_XSUB(b.x)], 1u);
        const unsigned gen = old / nloc;
        if (old + 1u == (gen + 1u) * nloc) {
            __builtin_amdgcn_fence(__ATOMIC_RELEASE, "agent");
            asm volatile("s_waitcnt vmcnt(0)" ::: "memory");
            const unsigned og = xb_add(&bar[XB_TOP], 1u);
            const unsigned tg = og / nx;
            if (og + 1u == (tg + 1u) * nx) xb_add(&bar[XB_TOPGEN], 1u);
            else XB_SPIN(xb_ld(&bar[XB_TOPGEN]) == tg, bar);
            __builtin_amdgcn_fence(__ATOMIC_ACQUIRE, "agent");
            xb_add(&bar[XB_XGEN(b.x)], 1u);
            asm volatile("s_waitcnt vmcnt(0)" ::: "memory");
        } else {
            XB_SPIN(xb_ld(&bar[XB_XGEN(b.x)]) == gen, bar);
            __builtin_amdgcn_fence(__ATOMIC_ACQUIRE, "agent");
            asm volatile("s_waitcnt vmcnt(0)" ::: "memory");
        }
    }
    __syncthreads();
}

constexpr int BM = 256, BK = 64, HALF = 128, HTB = HALF * BK * 2, STAGE_BYTES = 8 * HTB, NXCD = 8, WGM = 4;
__device__ __forceinline__ int lds_byte(int r, int c) { const int st = (r >> 4) * 2 + (c >> 5), rr = r & 15, cc = c & 31, ob = rr * 64 + cc * 2; return st * 1024 + (ob ^ (((ob >> 9) & 1) << 5)); }
__device__ __forceinline__ void stage_rc(int b, int& R, int& C) { const int st = b / 1024, sb = b % 1024, swz = sb ^ (((sb >> 9) & 1) << 5); R = (st >> 1) * 16 + swz / 64; C = (st & 1) * 32 + (swz % 64) / 2; }
__device__ __forceinline__ int perm32(int rho) { const int n = rho >> 4, i = rho & 15; return 8 * (i >> 2) + 4 * n + (i & 3); }

struct Unit { int pm, pn; };
struct Gemm { const bf16_t* A; const bf16_t* Bt; int lda, ldb, K, a_pn_off; };

struct StaticOrder {
    int nM, nN, nwg, G, c;
    __device__ __forceinline__ void init(int nM_, int nN_, int G_, int c_) { nM = nM_; nN = nN_; nwg = nM * nN; G = G_; c = c_; }
    __device__ __forceinline__ bool next(int i, Unit& u) const {
        const long Lx = (long)i * G + c; if (Lx >= nwg) return false;
        int wgid = (int)Lx; { const int q = nwg / NXCD, r = nwg % NXCD, xcd = wgid % NXCD, off = wgid / NXCD; wgid = (xcd < r ? xcd * (q + 1) : r * (q + 1) + (xcd - r) * q) + off; }
        const int nig = WGM * nN, gid = wgid / nig, fm = gid * WGM, gsz = (nM - fm) < WGM ? (nM - fm) : WGM;
        u.pm = fm + ((wgid % nig) % gsz); u.pn = (wgid % nig) / gsz; return true;
    }
};

template <class Epi>
__device__ __forceinline__ void gemm_phase(LAS unsigned char* lds, const Gemm g, const StaticOrder& S, const Epi& E, const int wave_s) {
    int tid_ = phase_tid(wave_s);
    const int tid = tid_, wid = __builtin_amdgcn_readfirstlane(tid >> 6), lane = tid & 63, wr = wid >> 2, wc = wid & 3, fr = lane & 15, fq = lane >> 4;
    const int K = g.K, nt = K / BK;
    unsigned voffA[2], voffB[2];
#pragma unroll
    for (int i = 0; i < 2; ++i) { int R, C; stage_rc(tid * 16 + i * 8192, R, C); const int Rb = (R & ~31) + perm32(R & 31);
        voffA[i] = (unsigned)(R * g.lda + C) * 2u; voffB[i] = (unsigned)(Rb * g.ldb + C) * 2u; }
    const size_t kstep = (size_t)(BK * 2);
    const size_t hstepA = (size_t)HALF * g.lda * 2, hstepB = (size_t)HALF * g.ldb * 2;
    const size_t tstepA = 2 * hstepA, tstepB = 2 * hstepB;
    const unsigned ldsw = (unsigned)wid * 1024u;
    const int aoff = lds_byte(wr * 64 + fr, fq * 8), boff = lds_byte(wc * 32 + fr, fq * 8);
#define PG8_SA(b, h) (((b) * 2 + (h)) * HTB)
#define PG8_SB(b, h) ((4 + (b) * 2 + (h)) * HTB)
#define PG8_STAGE(bufoff, gbase, voff) do { _Pragma("unroll") for (int _i = 0; _i < 2; ++_i) \
        __builtin_amdgcn_global_load_lds((const unsigned*)((const char*)(gbase) + (voff)[_i]), (LAS unsigned*)(lds + (bufoff) + ldsw + _i * 8192), 16, 0, 0); } while (0)
#define PG8_LDA(dst, b, h) do { _Pragma("unroll") for (int m = 0; m < 4; ++m) _Pragma("unroll") for (int k = 0; k < 2; ++k) dst[m][k] = *(const LAS bf16x8*)(lds + PG8_SA(b, h) + aoff + m * 2048 + k * 1024); } while (0)
#define PG8_LDB(dst, b, h) do { _Pragma("unroll") for (int n = 0; n < 2; ++n) _Pragma("unroll") for (int k = 0; k < 2; ++k) dst[n][k] = *(const LAS bf16x8*)(lds + PG8_SB(b, h) + boff + n * 2048 + k * 1024); } while (0)
#define PG8_MMA(ai, bj, At, Bt) do { __builtin_amdgcn_s_setprio(1); _Pragma("unroll") for (int m = 0; m < 4; ++m) _Pragma("unroll") for (int n = 0; n < 2; ++n) _Pragma("unroll") for (int k = 0; k < 2; ++k) \
        acc[ai][bj][m][n] = __builtin_amdgcn_mfma_f32_16x16x32_bf16(Bt[n][k], At[m][k], acc[ai][bj][m][n], 0, 0, 0); __builtin_amdgcn_s_setprio(0); } while (0)
#define PG8_WAIT_V(n) asm volatile("s_waitcnt vmcnt(" #n ")" ::: "memory")
#define PG8_WAIT_L(n) asm volatile("s_waitcnt lgkmcnt(" #n ")" ::: "memory")
#define PG8_BAR __builtin_amdgcn_s_barrier()
#define PG8_SCHED __builtin_amdgcn_sched_barrier(0)
    Unit cur, nxt; int ui = 0;
    if (!S.next(0, cur)) return;
    f32x4 acc[2][2][4][2];
#pragma unroll
    for (int a = 0; a < 2; ++a)
#pragma unroll
        for (int b = 0; b < 2; ++b)
#pragma unroll
            for (int m = 0; m < 4; ++m)
#pragma unroll
                for (int n = 0; n < 2; ++n) acc[a][b][m][n] = (f32x4){0.f, 0.f, 0.f, 0.f};
    bf16x8 At[4][2], B0[2][2], B1[2][2];
    float rsv[8];
#pragma unroll
    for (int i = 0; i < 8; ++i) rsv[i] = 0.f;
    const char* cA = (const char*)g.A + (size_t)cur.pm * tstepA + (size_t)cur.pn * g.a_pn_off; const char* cB = (const char*)g.Bt + (size_t)cur.pn * tstepB;
    PG8_STAGE(PG8_SB(0, 0), cB, voffB); PG8_STAGE(PG8_SA(0, 0), cA, voffA); PG8_STAGE(PG8_SB(0, 1), cB + hstepB, voffB); PG8_STAGE(PG8_SA(0, 1), cA + hstepA, voffA);
    if (wr == 1) PG8_BAR;
    PG8_WAIT_V(4); PG8_BAR;
    PG8_STAGE(PG8_SB(1, 0), cB + kstep, voffB); PG8_STAGE(PG8_SA(1, 0), cA + kstep, voffA); PG8_STAGE(PG8_SB(1, 1), cB + hstepB + kstep, voffB);
    PG8_WAIT_V(6); PG8_BAR;
    for (;;) {
        const bool has_next = S.next(ui + 1, nxt);
        const char* nA = has_next ? (const char*)g.A + (size_t)nxt.pm * tstepA + (size_t)nxt.pn * g.a_pn_off : cA; const char* nB = has_next ? (const char*)g.Bt + (size_t)nxt.pn * tstepB : cB;
        for (int t = 0; t < nt; t += 2) {
            const bool last = (t == nt - 2);
            const char* a1 = cA + (size_t)(t + 1) * kstep;
            const char* a2 = last ? nA : cA + (size_t)(t + 2) * kstep; const char* b2 = last ? nB : cB + (size_t)(t + 2) * kstep;
            const char* a3 = a2 + kstep; const char* b3 = b2 + kstep;
            if (last) E.prefetch(cur, wr, fr, rsv);
            PG8_LDB(B0, 0, 0); PG8_SCHED; PG8_LDA(At, 0, 0); PG8_STAGE(PG8_SA(1, 1), a1 + hstepA, voffA);
            PG8_WAIT_L(8); PG8_BAR; PG8_WAIT_L(0); PG8_MMA(0, 0, At, B0); PG8_BAR; PG8_SCHED;
            PG8_LDB(B1, 0, 1); PG8_STAGE(PG8_SB(0, 0), b2, voffB);
            PG8_BAR; PG8_WAIT_L(0); PG8_MMA(0, 1, At, B1); PG8_BAR;
            PG8_LDA(At, 0, 1); PG8_STAGE(PG8_SA(0, 0), a2, voffA);
            PG8_BAR; PG8_WAIT_L(0); PG8_MMA(1, 0, At, B0); PG8_BAR; PG8_SCHED;
            PG8_STAGE(PG8_SB(0, 1), b2 + hstepB, voffB);
            PG8_WAIT_V(6); PG8_BAR; PG8_MMA(1, 1, At, B1); PG8_BAR;
            PG8_LDB(B0, 1, 0); PG8_SCHED; PG8_LDA(At, 1, 0); PG8_STAGE(PG8_SA(0, 1), a2 + hstepA, voffA);
            PG8_WAIT_L(8); PG8_BAR; PG8_WAIT_L(0); PG8_MMA(0, 0, At, B0); PG8_BAR; PG8_SCHED;
            PG8_LDB(B1, 1, 1); PG8_STAGE(PG8_SB(1, 0), b3, voffB);
            PG8_BAR; PG8_WAIT_L(0); PG8_MMA(0, 1, At, B1); PG8_BAR;
            PG8_LDA(At, 1, 1); PG8_STAGE(PG8_SA(1, 0), a3, voffA);
            PG8_BAR; PG8_WAIT_L(0); PG8_MMA(1, 0, At, B0); PG8_BAR; PG8_SCHED;
            PG8_STAGE(PG8_SB(1, 1), b3 + hstepB, voffB);
            PG8_WAIT_V(6); PG8_BAR; PG8_MMA(1, 1, At, B1); PG8_BAR;
        }
        E(acc, cur, wr, wc, fr, fq, rsv);
        if (!has_next) break;
#pragma unroll
        for (int a = 0; a < 2; ++a)
#pragma unroll
            for (int b = 0; b < 2; ++b)
#pragma unroll
                for (int m = 0; m < 4; ++m)
#pragma unroll
                    for (int n = 0; n < 2; ++n) acc[a][b][m][n] = (f32x4){0.f, 0.f, 0.f, 0.f};
        cur = nxt; cA = nA; cB = nB; ++ui;
    }
    PG8_WAIT_V(0);
    if (wr == 0) PG8_BAR;
    PG8_BAR;
#undef PG8_SA
#undef PG8_SB
#undef PG8_STAGE
#undef PG8_LDA
#undef PG8_LDB
#undef PG8_MMA
#undef PG8_WAIT_V
#undef PG8_WAIT_L
#undef PG8_BAR
#undef PG8_SCHED
}

__device__ __forceinline__ float silu_mul(float g, float u) { return g * __builtin_amdgcn_rcpf(1.0f + __expf(-g)) * u; }

struct EpiSwiGLU {
    const float* ssq; bf16_t* act;
    __device__ __forceinline__ void prefetch(const Unit& u, int wr, int fr, float (&rsv)[8]) const {
#pragma unroll
        for (int ai = 0; ai < 2; ++ai)
#pragma unroll
            for (int m = 0; m < 4; ++m) rsv[ai * 4 + m] = ssq[u.pm * BM + wr * 64 + fr + ai * HALF + m * 16]; }
    __device__ __forceinline__ void operator()(const f32x4 (&acc)[2][2][4][2], const Unit& u, int wr, int wc, int fr, int fq, const float (&rsv)[8]) const {
        const int row0 = u.pm * BM + wr * 64 + fr, col0 = u.pn * 128 + wc * 32 + 8 * fq;
#pragma unroll
        for (int ai = 0; ai < 2; ++ai)
#pragma unroll
            for (int m = 0; m < 4; ++m) {
                const int row = row0 + ai * HALF + m * 16;
                {
                    const float rs = rsqrtf(rsv[ai * 4 + m] * (1.0f / D) + EPS), c1 = rs * -1.4426950408889634f, r2 = rs * rs;
                    u32x4 o;
#pragma unroll
                    for (int n = 0; n < 2; ++n) {
                        const f32x4 ga = acc[ai][0][m][n], ua = acc[ai][1][m][n];
                        const f32x4 t = ga * c1;
                        f32x4 d = {__builtin_amdgcn_exp2f(t[0]), __builtin_amdgcn_exp2f(t[1]), __builtin_amdgcn_exp2f(t[2]), __builtin_amdgcn_exp2f(t[3])};
                        d = d + 1.0f;
                        f32x4 r = {__builtin_amdgcn_rcpf(d[0]), __builtin_amdgcn_rcpf(d[1]), __builtin_amdgcn_rcpf(d[2]), __builtin_amdgcn_rcpf(d[3])};
                        const f32x4 v = (ga * ua) * (r * r2);
                        o[2 * n] = cvt_pk_bf16(v[0], v[1]); o[2 * n + 1] = cvt_pk_bf16(v[2], v[3]);
                    }
                    *(u32x4*)(act + (size_t)row * DFF + col0) = o;
                }
            }
    }
};

template <int MODE> struct EpiRes {
    const float* x; const float* meta; float* out; float* hmeta; bf16_t* hb; float* ssq;
    __device__ __forceinline__ void prefetch(const Unit&, int, int, float (&)[8]) const {}
    __device__ __forceinline__ void operator()(const f32x4 (&acc)[2][2][4][2], const Unit& u, int wr, int wc, int fr, int fq, const float (&rsv)[8]) const {
        const int row0 = u.pm * BM + wr * 64 + fr, col0 = u.pn * BM + wc * 32 + 8 * fq;
        const float fac = (MODE == 6) ? 1.0f : 0.5f;
#pragma unroll
        for (int ai = 0; ai < 2; ++ai) {
            f32x4 r[(MODE == 2) ? 4 : 1][2][2]; u32x4 hr[(MODE == 2) ? 1 : 4][2];
#pragma unroll
            for (int m = 0; m < 4; ++m)
#pragma unroll
                for (int bj = 0; bj < 2; ++bj) { const size_t off = (size_t)(row0 + ai * HALF + m * 16) * D + col0 + bj * HALF;
                    if (MODE == 2) { r[m][bj][0] = __builtin_nontemporal_load((const f32x4*)(x + off)); r[m][bj][1] = __builtin_nontemporal_load((const f32x4*)(x + off + 4)); }
                    else hr[m][bj] = (MODE == 8) ? __builtin_nontemporal_load((const u32x4*)(hb + off)) : *(const u32x4*)(hb + off); }
#pragma unroll
            for (int m = 0; m < 4; ++m) {
                const int row = row0 + ai * HALF + m * 16;
                float ss = 0.f;
#pragma unroll
                for (int bj = 0; bj < 2; ++bj) {
                    const int c = col0 + bj * HALF;
                    f32x4 r0, r1;
                    if (MODE == 2) { r0 = r[m][bj][0]; r1 = r[m][bj][1]; }
                    else { const u32x4 h = hr[m][bj]; r0 = (f32x4){bf_lo(h[0]), bf_hi(h[0]), bf_lo(h[1]), bf_hi(h[1])}; r1 = (f32x4){bf_lo(h[2]), bf_hi(h[2]), bf_lo(h[3]), bf_hi(h[3])}; }
                    const f32x4 v0 = r0 + acc[ai][bj][m][0] * fac, v1 = r1 + acc[ai][bj][m][1] * fac;
                    if (MODE == 8) { float* orow = out + (size_t)row * D; __builtin_nontemporal_store(v0, (f32x4*)(orow + c)); __builtin_nontemporal_store(v1, (f32x4*)(orow + c + 4)); }
                    else {
                        u32x4 o; o[0] = cvt_pk_bf16(v0[0], v0[1]); o[1] = cvt_pk_bf16(v0[2], v0[3]); o[2] = cvt_pk_bf16(v1[0], v1[1]); o[3] = cvt_pk_bf16(v1[2], v1[3]);
                        *(u32x4*)(hb + (size_t)row * D + c) = o;
                        ss += v0[0] * v0[0] + v0[1] * v0[1] + v0[2] * v0[2] + v0[3] * v0[3] + v1[0] * v1[0] + v1[1] * v1[1] + v1[2] * v1[2] + v1[3] * v1[3];
                    }
                }
                if (MODE != 8) { ss = xsum16_32(ss); if (fq == 0) atomicAdd(ssq + row, ss); }
            }
        }
    }
};

struct EpiZ {
    const float* ssq; bf16_t* z; float* flog; float* ssqqk;
    __device__ __forceinline__ void prefetch(const Unit& u, int wr, int fr, float (&rsv)[8]) const {
#pragma unroll
        for (int ai = 0; ai < 2; ++ai)
#pragma unroll
            for (int m = 0; m < 4; ++m) rsv[ai * 4 + m] = ssq[u.pm * BM + wr * 64 + fr + ai * HALF + m * 16]; }
    __device__ __forceinline__ void operator()(const f32x4 (&acc)[2][2][4][2], const Unit& u, int wr, int wc, int fr, int fq, const float (&rsv)[8]) const {
        const int row0 = u.pm * BM + wr * 64 + fr, col0 = u.pn * BM + wc * 32 + 8 * fq, pn = u.pn;
#pragma unroll
        for (int ai = 0; ai < 2; ++ai)
#pragma unroll
            for (int m = 0; m < 4; ++m) {
                const int row = row0 + ai * HALF + m * 16;
                const bool ok = row < M;
                const float rs = ok ? rsqrtf(rsv[ai * 4 + m] * (1.0f / D) + EPS) : 0.f;
                if (pn < 16) {
#pragma unroll
                    for (int bj = 0; bj < 2; ++bj) {
                        const f32x4 v0 = acc[ai][bj][m][0] * rs, v1 = acc[ai][bj][m][1] * rs;
                        if (ok) { u32x4 o; o[0] = cvt_pk_bf16(v0[0], v0[1]); o[1] = cvt_pk_bf16(v0[2], v0[3]); o[2] = cvt_pk_bf16(v1[0], v1[1]); o[3] = cvt_pk_bf16(v1[2], v1[3]);
                            *(u32x4*)(z + (size_t)row * ZW + col0 + bj * HALF) = o; }
                        if (pn >= 4 && pn < 12) {
                            float ss = v0[0] * v0[0] + v0[1] * v0[1] + v0[2] * v0[2] + v0[3] * v0[3] + v1[0] * v1[0] + v1[1] * v1[1] + v1[2] * v1[2] + v1[3] * v1[3];
                            ss = xsum16_32(ss);
                            if (fq == 0 && ok) ssqqk[(size_t)row * 64 + ((pn - 4) * 2 + bj) * 4 + wc] = ss;
                        }
                    }
                } else if (wc == 0 && fq == 0 && ok) {
                    *(f32x4*)(flog + (size_t)row * 8) = acc[ai][0][m][0] * rs; *(f32x4*)(flog + (size_t)row * 8 + 4) = acc[ai][0][m][1] * rs;
                }
            }
    }
};

struct EpiPlain {
    bf16_t* O;
    __device__ __forceinline__ void prefetch(const Unit&, int, int, float (&)[8]) const {}
    __device__ __forceinline__ void operator()(const f32x4 (&acc)[2][2][4][2], const Unit& u, int wr, int wc, int fr, int fq, const float (&rsv)[8]) const {
        const int row0 = u.pm * BM + wr * 64 + fr, col0 = u.pn * BM + wc * 32 + 8 * fq;
#pragma unroll
        for (int ai = 0; ai < 2; ++ai)
#pragma unroll
            for (int m = 0; m < 4; ++m) {
                const int row = row0 + ai * HALF + m * 16;
                if (row < M) {
#pragma unroll
                    for (int bj = 0; bj < 2; ++bj) {
                        const f32x4 v0 = acc[ai][bj][m][0], v1 = acc[ai][bj][m][1];
                        u32x4 o; o[0] = cvt_pk_bf16(v0[0], v0[1]); o[1] = cvt_pk_bf16(v0[2], v0[3]); o[2] = cvt_pk_bf16(v1[0], v1[1]); o[3] = cvt_pk_bf16(v1[2], v1[3]);
                        *(u32x4*)(O + (size_t)row * D + col0 + bj * HALF) = o;
                    }
                }
            }
    }
};

template <int MODE, int KSTEPS, int UNR>
__device__ __forceinline__ void skinny_phase(const Params& p, unsigned char* shm, int ctr_idx, int ntasks, const int wave_s) {
    unsigned char* ws = p.ws;
    int tid_ = phase_tid(wave_s);
    const int tid = tid_, wid = tid >> 6, lane = tid & 63, fr = lane & 15, quad = lane >> 4;
    f32x4* part = (f32x4*)shm;
    int* taskp = (int*)(shm + 16384);
    int* ctr = (int*)(ws + WS_CTR) + ctr_idx;
    const bf16_t* A = (MODE == 2) ? (const bf16_t*)(ws + WS_ACT) + (size_t)MX * DFF : (const bf16_t*)(ws + WS_HB) + (size_t)MX * D;
    const bf16_t* Bt = (const bf16_t*)(ws + (MODE == 1 ? WS_GU1 : MODE == 2 ? WS_D1 : WS_IN));
    constexpr int LDK = (MODE == 2) ? DFF : D;
    for (;;) {
        __syncthreads();
        if (tid == 0) *taskp = atomicAdd(ctr, 1);
        __syncthreads();
        const int cb = *taskp;
        if (cb >= ntasks) break;
        const int kbase = wid * KSTEPS * 32 + quad * 8;
        const bf16_t* ap = A + (size_t)fr * LDK + kbase;
        const int brow = (MODE == 1) ? ((cb >> 3) * 256 + (cb & 7) * 16 + fr) : cb * 16 + fr;
        const bf16_t* bp = Bt + (size_t)brow * LDK + kbase;
        f32x4 acc0 = {0.f, 0.f, 0.f, 0.f}, acc1 = {0.f, 0.f, 0.f, 0.f};
        for (int s0 = 0; s0 < KSTEPS; s0 += UNR) {
            bf16x8 av[UNR], b0[UNR], b1[UNR];
#pragma unroll
            for (int u = 0; u < UNR; ++u) { av[u] = *(const bf16x8*)(ap + (s0 + u) * 32); b0[u] = *(const bf16x8*)(bp + (s0 + u) * 32);
                if (MODE == 1) b1[u] = *(const bf16x8*)(bp + (size_t)128 * LDK + (s0 + u) * 32); }
#pragma unroll
            for (int u = 0; u < UNR; ++u) { acc0 = __builtin_amdgcn_mfma_f32_16x16x32_bf16(b0[u], av[u], acc0, 0, 0, 0);
                if (MODE == 1) acc1 = __builtin_amdgcn_mfma_f32_16x16x32_bf16(b1[u], av[u], acc1, 0, 0, 0); }
        }
        part[wid * 64 + lane] = acc0;
        if (MODE == 1) part[512 + wid * 64 + lane] = acc1;
        __syncthreads();
        if (wid == 0) {
            f32x4 a0 = part[lane], a1 = {0.f, 0.f, 0.f, 0.f};
#pragma unroll
            for (int w = 1; w < 8; ++w) a0 += part[w * 64 + lane];
            if (MODE == 1) { a1 = part[512 + lane];
#pragma unroll
                for (int w = 1; w < 8; ++w) a1 += part[512 + w * 64 + lane]; }
            const int row = MX + fr, c = cb * 16 + quad * 4;
            if (MODE == 1) {
                const float rs = rsqrtf(((const float*)(ws + WS_SSQ0))[row] * (1.0f / D) + EPS);
                u32x2 o; o[0] = cvt_pk_bf16(silu_mul(a0[0] * rs, a1[0] * rs), silu_mul(a0[1] * rs, a1[1] * rs)); o[1] = cvt_pk_bf16(silu_mul(a0[2] * rs, a1[2] * rs), silu_mul(a0[3] * rs, a1[3] * rs));
                *(u32x2*)((bf16_t*)(ws + WS_ACT) + (size_t)row * DFF + c) = o;
            } else if (MODE == 2) {
                const f32x4 v = *(const f32x4*)(p.in[1] + (size_t)fr * D + c) + a0 * 0.5f;
                *(f32x4*)((float*)(ws + WS_HMETA) + (size_t)fr * D + c) = v;
                u32x2 o; o[0] = cvt_pk_bf16(v[0], v[1]); o[1] = cvt_pk_bf16(v[2], v[3]);
                *(u32x2*)((bf16_t*)(ws + WS_HB) + (size_t)row * D + c) = o;
                float ss = v[0] * v[0] + v[1] * v[1] + v[2] * v[2] + v[3] * v[3];
                ss = xsum16_32(ss);
                if (quad == 0) atomicAdd((float*)(ws + WS_SSQ1) + row, ss);
            } else {
                const float rs = rsqrtf(((const float*)(ws + WS_SSQ1))[row] * (1.0f / D) + EPS);
                const f32x4 v = a0 * rs;
                if (cb < 256) {
                    u32x2 o; o[0] = cvt_pk_bf16(v[0], v[1]); o[1] = cvt_pk_bf16(v[2], v[3]);
                    *(u32x2*)((bf16_t*)(ws + WS_Z) + (size_t)row * ZW + c) = o;
                    if (cb >= 64 && cb < 192) {
                        float ss = v[0] * v[0] + v[1] * v[1] + v[2] * v[2] + v[3] * v[3];
                        ss = xsum16_32(ss);
                        if (quad == 0) atomicAdd((float*)(ws + WS_SSQQK) + (size_t)row * 64 + ((cb - 64) >> 3) * 4, ss);
                    }
                } else if (quad < 2) *(f32x4*)((float*)(ws + WS_FLOG) + (size_t)row * 8 + quad * 4) = v;
            }
        }
    }
}

struct TileDesc { const float* src; const float* gk; const float* sn; bf16_t* dst; int ldn, nvalid, k0, n0, dstK, drow0; };
constexpr int CT_LDB = 288  , CT_SLOT = 128 * CT_LDB;
__device__ __forceinline__ TileDesc cvt_decode(const Params& p, int ti) {
    constexpr int T_FF = 704, T_IN = 16 * 33, T_OUT = 16 * 16;
    unsigned char* ws = p.ws;
    TileDesc d; d.gk = nullptr; d.sn = nullptr;
    if (ti < 6 * T_FF) {
        const int job = ti / T_FF, r = ti - job * T_FF, layer = job / 3, kind = job - layer * 3;
        if (kind < 2) {
            const int tk = r / 44, tn = r - tk * 44;
            d.src = p.in[(layer ? 15 : 3) + kind]; d.dst = (bf16_t*)(ws + (layer ? WS_GU2 : WS_GU1)); d.gk = p.in[layer ? 14 : 2];
            d.ldn = DFF; d.nvalid = DFF; d.k0 = tk * 128; d.n0 = tn * 128; d.dstK = D; d.drow0 = tn * 256 + kind * 128;
        } else {
            const int tk = r / 16, tn = r - tk * 16;
            d.src = p.in[layer ? 17 : 5]; d.dst = (bf16_t*)(ws + (layer ? WS_D2 : WS_D1));
            d.ldn = D; d.nvalid = D; d.k0 = tk * 128; d.n0 = tn * 128; d.dstK = DFF; d.drow0 = tn * 128;
        }
    } else if (ti < 6 * T_FF + T_IN) {
        const int r = ti - 6 * T_FF, tk = r / 33, tn = r - tk * 33;
        d.src = p.in[7]; d.dst = (bf16_t*)(ws + WS_IN); d.gk = p.in[6];
        d.ldn = DIN; d.nvalid = DIN; d.k0 = tk * 128; d.n0 = tn * 128; d.dstK = D; d.drow0 = tn * 128;
    } else if (ti < 6 * T_FF + T_IN + T_OUT) {
        const int r = ti - 6 * T_FF - T_IN, tk = r >> 4, tn = r & 15;
        d.src = p.in[13]; d.dst = (bf16_t*)(ws + WS_OUT);
        d.ldn = D; d.nvalid = D; d.k0 = tk * 128; d.n0 = tn * 128; d.dstK = D; d.drow0 = tn * 128;
    } else {
        const int r = ti - 6 * T_FF - T_IN - T_OUT, g = r >> 2, tk = (r >> 1) & 1, tn = r & 1;
        d.src = p.in[11] + (size_t)g * 65536; d.dst = (bf16_t*)(ws + WS_POOL) + (size_t)g * 65536; d.sn = p.in[12] + g * 256;
        d.ldn = 256; d.nvalid = 256; d.k0 = tk * 128; d.n0 = tn * 128; d.dstK = 256; d.drow0 = tn * 128;
    }
    return d;
}
#define CVT_LOAD(d, v, gv) do { _Pragma("unroll") for (int _i = 0; _i < 8; ++_i) { const int idx = tid + _i * 512, k = idx >> 5, n = (d).n0 + (idx & 31) * 4; \
        v[_i] = (n < (d).nvalid) ? __builtin_nontemporal_load((const f32x4*)((d).src + (size_t)((d).k0 + k) * (d).ldn + n)) : (f32x4){0.f, 0.f, 0.f, 0.f};        \
        gv[_i] = (d).gk ? (d).gk[(d).k0 + k] : 1.0f; } } while (0)
#define CVT_PROCESS(cur, v, gv, MID) do { \
        _Pragma("unroll") for (int i = 0; i < 8; ++i) { const int idx = tid + i * 512, k = idx >> 5, n4 = idx & 31; \
            f32x4 sc = {1.f, 1.f, 1.f, 1.f}; if ((cur).sn) sc = *(const f32x4*)((cur).sn + (cur).n0 + n4 * 4); \
            const float g = gv[i]; u32x2 o; o[0] = cvt_pk_bf16(v[i][0] * g * sc[0], v[i][1] * g * sc[1]); o[1] = cvt_pk_bf16(v[i][2] * g * sc[2], v[i][3] * g * sc[3]); \
            *(u32x2*)(tile + k * CT_LDB + ((n4 * 8) ^ (((k >> 3) & 1) << 7))) = o; } \
        LDS_BARRIER(); \
        MID; \
        { const int w_ = tid >> 6, q_ = (tid >> 4) & 3, i_ = tid & 15; \
          _Pragma("unroll") for (int j = 0; j < 4; ++j) { const int kc = 4 * j + q_, kr = kc * 8 + (i_ >> 2); \
            LAS unsigned char* tp = (LAS unsigned char*)tile + kr * CT_LDB + ((32 * w_ + 8 * (i_ & 3)) ^ ((kc & 1) << 7)); \
            const s16x4 a = __builtin_amdgcn_ds_read_tr16_b64_v4i16((LAS s16x4*)tp), b = __builtin_amdgcn_ds_read_tr16_b64_v4i16((LAS s16x4*)(tp + 4 * CT_LDB)); \
            const bf16x8 o = {a[0], a[1], a[2], a[3], b[0], b[1], b[2], b[3]}; \
            *(bf16x8*)((cur).dst + (size_t)((cur).drow0 + 16 * w_ + i_) * (cur).dstK + (cur).k0 + kc * 8) = o; } } \
        LDS_BARRIER(); } while (0)

__device__ __forceinline__ void prep_phase(const Params& p, unsigned char* shm, const int wave_s) {
    unsigned char* tile = shm;
    unsigned char* ws = p.ws;
    int tid_ = phase_tid(wave_s);
    const int tid = tid_, wid = tid >> 6, lane = tid & 63;
    constexpr int T_ALL = 3 * 704;
    int ti = blockIdx.x;
    TileDesc cur = cvt_decode(p, ti);
    f32x4 v[8]; float gv[8];
    CVT_LOAD(cur, v, gv);
    { float* s1 = (float*)(ws + WS_SSQ1); float* s2 = (float*)(ws + WS_SSQ2); float* sq = (float*)(ws + WS_SSQQK);
      const int gt = blockIdx.x * 512 + tid, nth = gridDim.x * 512;
      for (int i = gt; i < MP; i += nth) { s1[i] = 0.f; s2[i] = 0.f; }
      for (int i = gt; i < (MX + NMETA) * 64; i += nth) sq[i] = 0.f;
      if (gt < 8) ((int*)(ws + WS_CTR))[gt] = 0; }
    { bf16_t* hb = (bf16_t*)(ws + WS_HB); float* ssq0 = (float*)(ws + WS_SSQ0);
      for (int row = blockIdx.x * 8 + wid; row < M; row += gridDim.x * 8) {
          const float* src = (row >= MX) ? p.in[1] + (size_t)(row - MX) * D : p.in[0] + (size_t)row * D;
          float ss = 0.f;
#pragma unroll
          for (int i = 0; i < 8; ++i) { const int c = i * 256 + lane * 4; const f32x4 x4 = __builtin_nontemporal_load((const f32x4*)(src + c));
              ss += x4[0] * x4[0] + x4[1] * x4[1] + x4[2] * x4[2] + x4[3] * x4[3];
              u32x2 o; o[0] = cvt_pk_bf16(x4[0], x4[1]); o[1] = cvt_pk_bf16(x4[2], x4[3]); *(u32x2*)(hb + (size_t)row * D + c) = o; }
          ss += __shfl_xor(ss, 1); ss += __shfl_xor(ss, 2); ss += __shfl_xor(ss, 4); ss += __shfl_xor(ss, 8); ss += __shfl_xor(ss, 16); ss += __shfl_xor(ss, 32);
          if (lane == 0) ssq0[row] = ss;
      } }
    for (;;) {
        const int tn_ = ti + gridDim.x; const bool has_next = tn_ < T_ALL;
        TileDesc nx = cur; f32x4 vn[8]; float gn[8];
        if (has_next) { nx = cvt_decode(p, tn_); CVT_LOAD(nx, vn, gn); }
        CVT_PROCESS(cur, v, gv, (void)0);
        if (!has_next) break;
        cur = nx; ti = tn_;
#pragma unroll
        for (int i = 0; i < 8; ++i) { v[i] = vn[i]; gv[i] = gn[i]; }
    }
}

template <int WHICH> __device__ __forceinline__ int cvt_qmap(int n) {
    if (WHICH == 0) return n < 800 ? 4224 + n : 2112 + (n - 800);
    return 3520 + n;
}
template <int WHICH> __device__ __forceinline__ void cvt_queue(const Params& p, unsigned char* shm, int ctr_idx, int count, const int wave_s) {
    unsigned char* tile = shm;
    volatile int* slot = (volatile int*)(shm + CT_SLOT);
    int* ctr = (int*)(p.ws + WS_CTR) + ctr_idx;
    int tid_ = phase_tid(wave_s);
    const int tid = tid_;
    __syncthreads();
    if (tid == 0) { slot[0] = atomicAdd(ctr, 1); slot[1] = atomicAdd(ctr, 1); }
    __syncthreads();
    int n_cur = slot[0], n_nxt = slot[1];
    if (n_cur >= count) return;
    TileDesc cur = cvt_decode(p, cvt_qmap<WHICH>(n_cur));
    f32x4 v[8]; float gv[8];
    CVT_LOAD(cur, v, gv);
    for (;;) {
        const bool has_next = n_nxt < count;
        TileDesc nx = cur; f32x4 vn[8]; float gn[8];
        if (has_next) { nx = cvt_decode(p, cvt_qmap<WHICH>(n_nxt)); CVT_LOAD(nx, vn, gn); }
        if (tid == 0) slot[2] = atomicAdd(ctr, 1);
        int n_after = 0;
        CVT_PROCESS(cur, v, gv, n_after = slot[2]);
        if (!has_next) break;
        cur = nx; n_nxt = n_after;
#pragma unroll
        for (int i = 0; i < 8; ++i) { v[i] = vn[i]; gv[i] = gn[i]; }
    }
}

__device__ __forceinline__ void flog_phase(const Params& p, unsigned char* shm, const int wave_s) {
    unsigned char* ws = p.ws;
    int tid_ = phase_tid(wave_s);
    const int tid = tid_, wid = tid >> 6, lane = tid & 63, fr = lane & 15, quad = lane >> 4;
    f32x4* part = (f32x4*)shm;
    for (int t2 = blockIdx.x; t2 < 256; t2 += gridDim.x) {
        const int task = t2 * 2 + (wid >> 2), kq = wid & 3;
        const bf16_t* hp = (const bf16_t*)(ws + WS_HB) + (size_t)(task * 16 + fr) * D + kq * 512 + quad * 8;
        const bf16_t* wp = (const bf16_t*)(ws + WS_IN) + (size_t)(4096 + fr) * D + kq * 512 + quad * 8;
        f32x4 acc = {0.f, 0.f, 0.f, 0.f};
#pragma unroll
        for (int s0 = 0; s0 < 16; s0 += 8) {
            bf16x8 hv[8], wv[8];
#pragma unroll
            for (int u = 0; u < 8; ++u) { hv[u] = *(const bf16x8*)(hp + (s0 + u) * 32); wv[u] = *(const bf16x8*)(wp + (s0 + u) * 32); }
#pragma unroll
            for (int u = 0; u < 8; ++u) acc = __builtin_amdgcn_mfma_f32_16x16x32_bf16(wv[u], hv[u], acc, 0, 0, 0);
        }
        __syncthreads();
        part[wid * 64 + lane] = acc;
        __syncthreads();
        if ((wid & 3) == 0) {
            const f32x4 a = part[wid * 64 + lane] + part[(wid + 1) * 64 + lane] + part[(wid + 2) * 64 + lane] + part[(wid + 3) * 64 + lane];
            const int row = task * 16 + fr;
            const float rs = rsqrtf(((const float*)(ws + WS_SSQ1))[row] * (1.0f / D) + EPS);
            if (quad < 2) *(f32x4*)((float*)(ws + WS_FLOG) + (size_t)row * 8 + quad * 4) = a * rs;
        }
    }
}

__device__ __forceinline__ float log_sigmoid(float v) { return fminf(v, 0.f) - log1pf(expf(-fabsf(v))); }
template <int W> __device__ __forceinline__ void pooled_item(const bf16_t* __restrict__ z, bf16_t* __restrict__ pb  , int b, int t0  , int c0) {
    u32x4 r[W + 7];
#pragma unroll
    for (int i = 0; i < W + 7; ++i) { const int t = t0 - (W - 1) + i; r[i] = (t >= 0) ? *(const u32x4*)(z + (size_t)grow_of(b, t) * ZW + c0) : (u32x4){0u, 0u, 0u, 0u}; }
    float a[8] = {0.f, 0.f, 0.f, 0.f, 0.f, 0.f, 0.f, 0.f};
#pragma unroll
    for (int i = 0; i < W - 1; ++i)
#pragma unroll
        for (int e = 0; e < 4; ++e) { a[2 * e] += bf_lo(r[i][e]); a[2 * e + 1] += bf_hi(r[i][e]); }
#pragma unroll
    for (int i = 0; i < 8; ++i) {
        const u32x4 cur = r[W - 1 + i];
#pragma unroll
        for (int e = 0; e < 4; ++e) { a[2 * e] += bf_lo(cur[e]); a[2 * e + 1] += bf_hi(cur[e]); }
        const int t = t0 + i, cnt = (t + 1 < W) ? t + 1 : W;
        const float inv = 1.0f / (float)cnt;
        u32x4 o;
#pragma unroll
        for (int e = 0; e < 4; ++e) o[e] = cvt_pk_bf16(a[2 * e] * inv - bf_lo(cur[e]), a[2 * e + 1] * inv - bf_hi(cur[e]));
        *(u32x4*)(pb + (size_t)(t - NMETA) * 1024 + c0) = o;
#pragma unroll
        for (int e = 0; e < 4; ++e) { a[2 * e] -= bf_lo(r[i][e]); a[2 * e + 1] -= bf_hi(r[i][e]); }
    }
}
__device__ __forceinline__ void mid_phase(const Params& p, unsigned char* shm, const int wave_s) {
    unsigned char* ws = p.ws;
    int tid_ = phase_tid(wave_s);
    const int tid = tid_, lane = tid & 63, wid = tid >> 6;
    const bf16_t* z = (const bf16_t*)(ws + WS_Z);
    if (blockIdx.x < 32) {
        const int bh = blockIdx.x, b = bh >> 3, h = bh & 7;
        const float* flog = (const float*)(ws + WS_FLOG); float* cum = (float*)(ws + WS_CUM);
        float* wtot = (float*)shm;
        const float bf = p.in[8][h];
        const int t0 = tid * 5;
        float lf[5]; float tot = 0.f;
#pragma unroll
        for (int i = 0; i < 5; ++i) { const int t = t0 + i; lf[i] = (t < L) ? log_sigmoid(flog[(size_t)grow_of(b, t) * 8 + h] + bf) : 0.f; tot += lf[i]; }
        float inc = tot;
#pragma unroll
        for (int o = 1; o < 64; o <<= 1) { const float y = __shfl_up(inc, o); if (lane >= o) inc += y; }
        if (lane == 63) wtot[wid] = inc;
        __syncthreads();
        float run = inc - tot;
        for (int w = 0; w < wid; ++w) run += wtot[w];
#pragma unroll
        for (int i = 0; i < 5; ++i) { const int t = t0 + i; run += lf[i]; if (t < L) cum[bh * CUML + t] = run; }
    }
    if (blockIdx.x < 32) {
        __syncthreads();
        if (tid == 0) { __builtin_amdgcn_fence(__ATOMIC_RELEASE, "agent"); asm volatile("s_waitcnt vmcnt(0)" ::: "memory");
            __hip_atomic_fetch_add((int*)(ws + WS_CTR) + 7, 1, __ATOMIC_RELAXED, __HIP_MEMORY_SCOPE_AGENT); }
    }
}
__device__ __forceinline__ void pooled_for_unit(const Params& p, const int upm, const int upn, const int wave_s) {
    unsigned char* ws = p.ws;
    const int tid = phase_tid(wave_s);
    const bf16_t* z = (const bf16_t*)(ws + WS_Z); bf16_t* pooled = (bf16_t*)(ws + WS_POOLED);
    const int b = upm >> 3, g = upn;
    bf16_t* pb = pooled + (size_t)b * SEQ * 1024;
#pragma unroll
    for (int i = 0; i < 2; ++i) { const int idx = tid + i * 512, rc = idx >> 5, cc = idx & 31;
        const int t0 = NMETA + (upm & 7) * 256 + rc * 8, c0 = g * 256 + cc * 8;
        if (g == 0) pooled_item<2>(z, pb, b, t0, c0); else if (g == 1) pooled_item<4>(z, pb, b, t0, c0); else if (g == 2) pooled_item<8>(z, pb, b, t0, c0); else pooled_item<16>(z, pb, b, t0, c0); }
}

constexpr int V_LDB = 288  ;
constexpr int KS_LD = 144  , VT_LD = 72, AT_VT = 64 * KS_LD * 2, AT_KSC = AT_VT + 128 * VT_LD * 2, AT_KCM = AT_KSC + 256, AT_BUF = AT_KCM + 256  , AT_ITEM = 2 * AT_BUF;
constexpr int N_ITEMS = 32 * 16;
__device__ __forceinline__ void attn_phase(const Params& p, unsigned char* shm, int ctr_idx, const int wave_s) {
    unsigned char* ws = p.ws;
    int tid_ = phase_tid(wave_s);
    const int tid = tid_, wid = tid >> 6, lane = tid & 63, fr = lane & 15, quad = lane >> 4;
    int* itemp = (int*)(shm + AT_ITEM);
    const bf16_t* z = (const bf16_t*)(ws + WS_Z); const float* ssqqk = (const float*)(ws + WS_SSQQK); const float* cum = (const float*)(ws + WS_CUM);
    bf16_t* mix = (bf16_t*)(ws + WS_MIX); int* ctr = (int*)(ws + WS_CTR) + ctr_idx;
    const float* gq = p.in[9]; const float* gkn = p.in[10];
    const float LOG2E = 1.4426950408889634f;
    for (;;) {
        __syncthreads();
        if (tid == 0) *itemp = atomicAdd(ctr, 1);
        __syncthreads();
        const int item = *itemp;
        if (item >= N_ITEMS) break;
        const int j = 16 - item / 32, bh = item & 31, b = bh >> 3, h = bh & 7;
        const int rowbase = 16 + 128 * (j - 1), ntiles = 2 * j + 1;
        const bool wvalid = true;
        const int qr0 = rowbase + 16 * wid;
        const int qrow = qr0 + fr; const size_t grow = (size_t)b * SEQ + (qrow - NMETA);
        const f32x4 qss = *(const f32x4*)(ssqqk + grow * 64 + h * 4);
        const float qs = rsqrtf((qss[0] + qss[1] + qss[2] + qss[3]) * (1.0f / DHD) + EPS) * 0.08838834764831845f;
        bf16x8 qf[4]; float gmax = 0.f;
#pragma unroll
        for (int ks = 0; ks < 4; ++ks) { const int d0 = ks * 32 + quad * 8;
            const u32x4 raw = *(const u32x4*)(z + grow * ZW + 1024 + h * DHD + d0);
            const f32x4 a0 = *(const f32x4*)(gq + d0), a1 = *(const f32x4*)(gq + d0 + 4), b0 = *(const f32x4*)(gkn + d0), b1 = *(const f32x4*)(gkn + d0 + 4);
            u32x4 o;
            o[0] = cvt_pk_bf16(bf_lo(raw[0]) * a0[0] * b0[0] * qs, bf_hi(raw[0]) * a0[1] * b0[1] * qs); o[1] = cvt_pk_bf16(bf_lo(raw[1]) * a0[2] * b0[2] * qs, bf_hi(raw[1]) * a0[3] * b0[3] * qs);
            o[2] = cvt_pk_bf16(bf_lo(raw[2]) * a1[0] * b1[0] * qs, bf_hi(raw[2]) * a1[1] * b1[1] * qs); o[3] = cvt_pk_bf16(bf_lo(raw[3]) * a1[2] * b1[2] * qs, bf_hi(raw[3]) * a1[3] * b1[3] * qs);
#pragma unroll
            for (int e = 0; e < 4; ++e) gmax = fmaxf(gmax, fmaxf(fabsf(a0[e] * b0[e]), fabsf(a1[e] * b1[e])));
            qf[ks] = __builtin_bit_cast(bf16x8, o); }
        gmax = fmaxf(gmax, __shfl_xor(gmax, 16)); gmax = fmaxf(gmax, __shfl_xor(gmax, 32));
        const float Coff = gmax * (128.0f * 0.08838834764831845f);
        const float cumq = (cum[bh * CUML + qrow] - Coff) * LOG2E;
        const int vlane = (8 * quad + (fr >> 2)) * V_LDB + ((fr & 3) >> 1) * 16 + 8 * (fr & 1);
        f32x4 O[8];
#pragma unroll
        for (int i = 0; i < 8; ++i) O[i] = (f32x4){0.f, 0.f, 0.f, 0.f};
        float lsum = 0.f;
        u32x4 kreg0[2], vreg0[2], kreg1[2], vreg1[2]; f32x4 kss_r0 = {0.f, 0.f, 0.f, 0.f}, kss_r1 = {0.f, 0.f, 0.f, 0.f}; float kcm_r0 = 0.f, kcm_r1 = 0.f;
#define AT_PREFETCH(kt, R) do { _Pragma("unroll") for (int _i = 0; _i < 2; ++_i) { const int idx = tid + _i * 512, key = idx >> 4, ch = idx & 15; int gkey = (kt) * 64 + key; gkey = gkey < L ? gkey : L - 1; \
            const bf16_t* rp = z + (size_t)grow_of(b, gkey) * ZW + h * DHD + ch * 8; kreg##R[_i] = *(const u32x4*)(rp + 2048); vreg##R[_i] = *(const u32x4*)(rp + 3072); } \
            if (tid < 64) { int gkey = (kt) * 64 + tid; gkey = gkey < L ? gkey : L - 1; kss_r##R = *(const f32x4*)(ssqqk + (size_t)grow_of(b, gkey) * 64 + (8 + h) * 4); kcm_r##R = cum[bh * CUML + gkey]; } } while (0)
#define AT_WRITE(bufp, R) do { bf16_t* Ks_ = (bf16_t*)(bufp); unsigned char* Vb_ = (bufp) + AT_VT; \
            _Pragma("unroll") for (int i = 0; i < 2; ++i) { const int idx = tid + i * 512, key = idx >> 4, ch = idx & 15; \
                const int rho = (key & 32) + ((key >> 2) & 1) * 16 + ((key & 31) >> 3) * 4 + (key & 3); \
                *(u32x4*)(Ks_ + rho * KS_LD + ch * 8) = kreg##R[i]; \
                *(u32x4*)(Vb_ + key * V_LDB + ((ch ^ (((key >> 3) & 1) << 3)) << 4)) = vreg##R[i]; } \
            if (tid < 64) { ((float*)((bufp) + AT_KSC))[tid] = rsqrtf((kss_r##R[0] + kss_r##R[1] + kss_r##R[2] + kss_r##R[3]) * (1.0f / DHD) + EPS) * LOG2E; ((float*)((bufp) + AT_KCM))[tid] = kcm_r##R * LOG2E; } } while (0)
        auto tile_compute = [&](const int kt) __attribute__((always_inline)) {
            unsigned char* bufc = shm + (kt & 1) * AT_BUF;
            const bf16_t* Ks = (const bf16_t*)bufc;
            LAS unsigned char* vA = (LAS unsigned char*)(bufc + AT_VT) + vlane + (quad & 1) * 128; LAS unsigned char* vB = (LAS unsigned char*)(bufc + AT_VT) + vlane - (quad & 1) * 128;
            const float* kscl = (const float*)(bufc + AT_KSC); const float* kcm = (const float*)(bufc + AT_KCM);
            if (kt * 64 <= qr0 + 15) {
                f32x4 S[4];
#pragma unroll
                for (int blk = 0; blk < 4; ++blk) { S[blk] = (f32x4){0.f, 0.f, 0.f, 0.f};
#pragma unroll
                    for (int ks = 0; ks < 4; ++ks) { const bf16x8 kf = *(const bf16x8*)(Ks + (blk * 16 + fr) * KS_LD + ks * 32 + quad * 8);
                        S[blk] = __builtin_amdgcn_mfma_f32_16x16x32_bf16(kf, qf[ks], S[blk], 0, 0, 0); } }
                const bool need_mask = (kt * 64 + 63 > qr0);
                const f32x4 cq4 = {cumq, cumq, cumq, cumq};
#pragma unroll
                for (int blk = 0; blk < 4; ++blk) { const int kb = (blk >> 1) * 32 + quad * 8 + (blk & 1) * 4;
                    const f32x4 sc = *(const f32x4*)(kscl + kb), cm = *(const f32x4*)(kcm + kb);
                    S[blk] = S[blk] * sc + (cq4 - cm); }
                if (need_mask) {
#pragma unroll
                    for (int blk = 0; blk < 4; ++blk) { const int kb = (blk >> 1) * 32 + quad * 8 + (blk & 1) * 4;
#pragma unroll
                        for (int i = 0; i < 4; ++i) if (kt * 64 + kb + i > qrow) S[blk][i] = -1e30f; } }
#pragma unroll
                for (int blk = 0; blk < 4; ++blk)
#pragma unroll
                    for (int i = 0; i < 4; ++i) S[blk][i] = __builtin_amdgcn_exp2f(S[blk][i]);
                { const f32x4 s4 = (S[0] + S[1]) + (S[2] + S[3]); lsum += (s4[0] + s4[1]) + (s4[2] + s4[3]); }
                bf16x8 pf[2];
#pragma unroll
                for (int G = 0; G < 2; ++G) { u32x4 o; o[0] = cvt_pk_bf16(S[2 * G][0], S[2 * G][1]); o[1] = cvt_pk_bf16(S[2 * G][2], S[2 * G][3]);
                    o[2] = cvt_pk_bf16(S[2 * G + 1][0], S[2 * G + 1][1]); o[3] = cvt_pk_bf16(S[2 * G + 1][2], S[2 * G + 1][3]); pf[G] = __builtin_bit_cast(bf16x8, o); }
#pragma unroll
                for (int db = 0; db < 8; ++db)
#pragma unroll
                    for (int G = 0; G < 2; ++G) { LAS unsigned char* vp = (db < 4 ? vA : vB) + (32 * G) * V_LDB + 32 * db;
                        const s16x4 v0 = __builtin_amdgcn_ds_read_tr16_b64_v4i16((LAS s16x4*)vp), v1 = __builtin_amdgcn_ds_read_tr16_b64_v4i16((LAS s16x4*)(vp + 4 * V_LDB));
                        const bf16x8 vf = {v0[0], v0[1], v0[2], v0[3], v1[0], v1[1], v1[2], v1[3]};
                        O[db] = __builtin_amdgcn_mfma_f32_16x16x32_bf16(vf, pf[G], O[db], 0, 0, 0); }
            }
        };
        AT_PREFETCH(0, 0);
        AT_WRITE(shm, 0);
        AT_PREFETCH(1, 1);
        AT_PREFETCH(2, 0);
        LDS_BARRIER();
        for (int kt = 0; kt < ntiles; kt += 2) {
            if (kt + 1 < ntiles) AT_WRITE(shm + AT_BUF, 1);
            if (kt + 3 < ntiles) AT_PREFETCH(kt + 3, 1);
            tile_compute(kt);
            LDS_BARRIER();
            if (kt + 1 < ntiles) {
                if (kt + 2 < ntiles) AT_WRITE(shm, 0);
                if (kt + 4 < ntiles) AT_PREFETCH(kt + 4, 0);
                tile_compute(kt + 1);
                LDS_BARRIER();
            }
        }
#undef AT_PREFETCH
#undef AT_WRITE
        lsum = xsum16_32(lsum);
        const float inv = 1.0f / lsum;
        if (wvalid) {
#pragma unroll
            for (int db = 0; db < 8; ++db) { u32x2 o; o[0] = cvt_pk_bf16(O[db][0] * inv, O[db][1] * inv); o[1] = cvt_pk_bf16(O[db][2] * inv, O[db][3] * inv);
                *(u32x2*)(mix + grow * D + 1024 + h * DHD + db * 16 + quad * 4) = o; }
        }
    }
}

constexpr int LDS_BYTES = STAGE_BYTES + 16;
__global__ __launch_bounds__(512, 2) void hymba_fwd(Params p) {
    extern __shared__ __attribute__((aligned(16))) unsigned char shm[];
    LAS unsigned char* lds = (LAS unsigned char*)shm;
    cg::grid_group grid = cg::this_grid();
    unsigned char* ws = p.ws;
    bf16_t* hb = (bf16_t*)(ws + WS_HB); bf16_t* act = (bf16_t*)(ws + WS_ACT); bf16_t* z = (bf16_t*)(ws + WS_Z); bf16_t* mix = (bf16_t*)(ws + WS_MIX);
    float* hmeta = (float*)(ws + WS_HMETA);
    float* ssq0 = (float*)(ws + WS_SSQ0); float* ssq1 = (float*)(ws + WS_SSQ1); float* ssq2 = (float*)(ws + WS_SSQ2);
    const int G = gridDim.x, c = blockIdx.x;
    const int wave_s = __builtin_amdgcn_readfirstlane((int)threadIdx.x >> 6);
    StaticOrder S;
    if (phase_tid(wave_s) == 0) { *(volatile LAS unsigned*)(lds + STAGE_BYTES) = 0u; *(volatile LAS unsigned*)(lds + STAGE_BYTES + 4) = 0u; }
    __syncthreads();
    const XcdBarrier xb = xcd_barrier_post((unsigned*)(ws + WS_BAR), (volatile LAS unsigned*)(lds + STAGE_BYTES), wave_s);

    prep_phase(p, shm, wave_s);
    if (p.ws == nullptr) grid.sync();
    xcd_barrier(xb, wave_s);
    { Gemm g{hb, (const bf16_t*)(ws + WS_GU1), D, D, D, 0}; S.init(32, 44, G, c); EpiSwiGLU E{ssq0, act}; gemm_phase(lds, g, S, E, wave_s);
    }
    skinny_phase<1, 8, 8>(p, shm, 1, 352, wave_s);
    cvt_queue<0>(p, shm, 4, 800 + 1408, wave_s);
    xcd_barrier(xb, wave_s);
    { Gemm g{act, (const bf16_t*)(ws + WS_D1), DFF, DFF, DFF, 0}; S.init(32, 8, G, c); EpiRes<2> E{p.in[0], p.in[1], p.out, hmeta, hb, ssq1}; gemm_phase(lds, g, S, E, wave_s); }
    skinny_phase<2, 22, 11>(p, shm, 2, 128, wave_s);
    xcd_barrier(xb, wave_s);
    { Gemm g{hb, (const bf16_t*)(ws + WS_IN), D, D, D, 0}; S.init(32, 16, G, c); EpiZ E{ssq1, z, (float*)(ws + WS_FLOG), (float*)(ws + WS_SSQQK)}; gemm_phase(lds, g, S, E, wave_s); }
    skinny_phase<3, 8, 8>(p, shm, 3, 257, wave_s);
    flog_phase(p, shm, wave_s);
    xcd_barrier(xb, wave_s);
    mid_phase(p, shm, wave_s);
    { Gemm g{(const bf16_t*)(ws + WS_POOLED), (const bf16_t*)(ws + WS_POOL), 1024, 256, 256, 512}; S.init(32, 4, G, c); EpiPlain E{mix};
      for (int i = 0;; ++i) { Unit u; if (!S.next(i, u)) break; pooled_for_unit(p, u.pm, u.pn, wave_s); }
      asm volatile("s_waitcnt vmcnt(0)" ::: "memory"); __syncthreads();
      gemm_phase(lds, g, S, E, wave_s); }
    { if (phase_tid(wave_s) == 0) { int* flag = (int*)(ws + WS_CTR) + 7; unsigned sp = 0;
          while (__hip_atomic_load(flag, __ATOMIC_RELAXED, __HIP_MEMORY_SCOPE_AGENT) < 32) { __builtin_amdgcn_s_sleep(1); if (++sp > (1u << 22)) break; }
          __builtin_amdgcn_fence(__ATOMIC_ACQUIRE, "agent"); asm volatile("s_waitcnt vmcnt(0)" ::: "memory"); }
      __syncthreads(); }
    attn_phase(p, shm, 0, wave_s);
    xcd_barrier(xb, wave_s);
    { Gemm g{mix, (const bf16_t*)(ws + WS_OUT), D, D, D, 0}; S.init(32, 8, G, c); EpiRes<6> E{p.in[0], p.in[1], p.out, hmeta, hb, ssq2}; gemm_phase(lds, g, S, E, wave_s); }
    xcd_barrier(xb, wave_s);
    { Gemm g{hb, (const bf16_t*)(ws + WS_GU2), D, D, D, 0}; S.init(32, 44, G, c); EpiSwiGLU E{ssq2, act}; gemm_phase(lds, g, S, E, wave_s); }
    cvt_queue<1>(p, shm, 5, 704, wave_s);
    xcd_barrier(xb, wave_s);
    { Gemm g{act, (const bf16_t*)(ws + WS_D2), DFF, DFF, DFF, 0}; S.init(32, 8, G, c); EpiRes<8> E{p.in[0], p.in[1], p.out, hmeta, hb, ssq2}; gemm_phase(lds, g, S, E, wave_s); }
}

extern "C" void kernel_launch(void* const* d_in, const int* in_sizes, int n_in, void* d_out, int out_size, void* d_ws, size_t ws_size, hipStream_t stream) {
    static int grid_blocks = 0;
    if (grid_blocks == 0) {
        if (n_in != 18 || ws_size < WS_END) { fprintf(stderr, "kernel_launch: need 18 inputs and %zu bytes of workspace (got %d, %zu)\n", (size_t)WS_END, n_in, ws_size); grid_blocks = -1; return; }
        int dev = 0, cus = 0, per_cu = 0;
        (void)hipGetDevice(&dev);
        (void)hipDeviceGetAttribute(&cus, hipDeviceAttributeMultiprocessorCount, dev);
        (void)hipFuncSetAttribute((const void*)hymba_fwd, hipFuncAttributeMaxDynamicSharedMemorySize, LDS_BYTES);
        (void)hipOccupancyMaxActiveBlocksPerMultiprocessor(&per_cu, (const void*)hymba_fwd, 512, LDS_BYTES);
        if (per_cu < 1) per_cu = 1;
        grid_blocks = cus * per_cu;
    }
    if (grid_blocks < 0) return;
    if (hipMemsetAsync((char*)d_ws + WS_BAR, 0, XCD_BAR_WORDS * 4, stream) != hipSuccess) { fprintf(stderr, "memset failed\n"); return; }
    Params p{};
    for (int i = 0; i < 18; ++i) p.in[i] = (const float*)d_in[i];
    p.out = (float*)d_out; p.ws = (unsigned char*)d_ws;
    void* args[] = {&p};
    hipError_t e = hipLaunchCooperativeKernel((const void*)hymba_fwd, dim3(grid_blocks), dim3(512), args, LDS_BYTES, stream);
    if (e != hipSuccess) fprintf(stderr, "cooperative launch failed: %s (grid %d)\n", hipGetErrorString(e), grid_blocks);
}
```

```cpp
#include <hip/hip_runtime.h>
#include <hip/hip_cooperative_groups.h>
#include <cstdio>
namespace cg = cooperative_groups;

#define LAS __attribute__((address_space(3)))
typedef unsigned short bf16_t;
typedef short bf16x8 __attribute__((ext_vector_type(8)));
typedef float f32x4 __attribute__((ext_vector_type(4)));
typedef unsigned u32x4 __attribute__((ext_vector_type(4)));
typedef unsigned u32x2 __attribute__((ext_vector_type(2)));
typedef short s16x4 __attribute__((ext_vector_type(4)));

constexpr int D = 2048, NB = 4, SEQ = 2048, NMETA = 16, L = NMETA + SEQ  , MX = NB * SEQ  , M = MX + NMETA  , MP = 8448;
constexpr int DFF = 5632, DIN = 4104, NH = 8, DHD = 128, ZW = 4096  , CUML = 2112;
constexpr float EPS = 1e-6f;

constexpr size_t al256(size_t x) { return (x + 255) & ~(size_t)255; }
constexpr size_t WS_GU1 = 0;
constexpr size_t WS_D1 = WS_GU1 + (size_t)2 * DFF * D * 2;
constexpr size_t WS_IN = WS_D1 + (size_t)D * DFF * 2;
constexpr size_t WS_OUT = WS_IN + (size_t)4352 * D * 2;
constexpr size_t WS_POOL = WS_OUT + (size_t)D * D * 2;
constexpr size_t WS_GU2 = WS_POOL + (size_t)1024 * 256 * 2;
constexpr size_t WS_D2 = WS_GU2 + (size_t)2 * DFF * D * 2;
constexpr size_t WS_HB = WS_D2 + (size_t)D * DFF * 2;
constexpr size_t WS_ACT = WS_HB + (size_t)MP * D * 2;
constexpr size_t WS_Z = WS_ACT;
constexpr size_t WS_POOLED = WS_Z + (size_t)MP * ZW * 2;
constexpr size_t WS_MIX = WS_ACT + (size_t)MP * DFF * 2;
constexpr size_t WS_HMETA = WS_MIX + (size_t)MP * D * 2;
constexpr size_t WS_FLOG = WS_HMETA + (size_t)NMETA * D * 4;
constexpr size_t WS_CUM = WS_FLOG + (size_t)MP * 8 * 4;
constexpr size_t WS_SSQ0 = WS_CUM + (size_t)32 * CUML * 4;
constexpr size_t WS_SSQ1 = WS_SSQ0 + (size_t)MP * 4;
constexpr size_t WS_SSQ2 = WS_SSQ1 + (size_t)MP * 4;
constexpr size_t WS_SSQQK = WS_SSQ2 + (size_t)MP * 4;
constexpr size_t WS_CTR = WS_SSQQK + (size_t)MP * 64 * 4;
constexpr size_t WS_BAR = WS_CTR + 256;
constexpr size_t WS_END = WS_BAR + 3456 * 4;
static_assert(WS_POOLED + (size_t)MP * 1024 * 2 <= WS_MIX, "z + pooled must fit in the act region");

struct Params { const float* in[18]; float* out; unsigned char* ws; };

__device__ __forceinline__ unsigned cvt_pk_bf16(float lo, float hi) { unsigned r; asm volatile("v_cvt_pk_bf16_f32 %0, %1, %2" : "=v"(r) : "v"(lo), "v"(hi)); return r; }
#define LDS_BARRIER() do { asm volatile("s_waitcnt lgkmcnt(0)" ::: "memory"); __builtin_amdgcn_s_barrier(); asm volatile("" ::: "memory"); } while (0)
__device__ __forceinline__ int phase_tid(int wave_s) { int lane; asm volatile("v_mbcnt_lo_u32_b32 %0, -1, 0\n\tv_mbcnt_hi_u32_b32 %0, -1, %0" : "=v"(lane)); return wave_s * 64 + lane; }
__device__ __forceinline__ float bf_lo(unsigned u) { return __uint_as_float(u << 16); }
__device__ __forceinline__ float bf_hi(unsigned u) { return __uint_as_float(u & 0xffff0000u); }
__device__ __forceinline__ int grow_of(int b, int pos) { return pos < NMETA ? MX + pos : b * SEQ + pos - NMETA; }
__device__ __forceinline__ float xsum16_32(float v) { v += __shfl_xor(v, 16); v += __shfl_xor(v, 32); return v; }


#define XB_TMO      128
#define XB_XCNT(j)  (256  + 64 * (j))
#define XB_XSUB(j)  (1280 + 64 * (j))
#define XB_XGEN(j)  (2304 + 64 * (j))
#define XB_TOP      3328
#define XB_TOPGEN   3392
#define XCD_BAR_WORDS 3456
#define XB_SPIN_CAP (1u << 18)
__device__ __forceinline__ unsigned xb_ld(unsigned* p)              { return __hip_atomic_load(p, __ATOMIC_RELAXED, __HIP_MEMORY_SCOPE_AGENT); }
__device__ __forceinline__ unsigned xb_add(unsigned* p, unsigned v) { return __hip_atomic_fetch_add(p, v, __ATOMIC_RELAXED, __HIP_MEMORY_SCOPE_AGENT); }
__device__ __forceinline__ unsigned xb_xcc_id() { return (unsigned)__builtin_amdgcn_s_getreg((3 << 11) | 20) & 0xFu; }
#define XB_SPIN(cond, bar) do { unsigned _sp = 0; while (cond) { __builtin_amdgcn_s_sleep(1); \
    if ((++_sp & 255u) == 0u) { if (xb_ld(&(bar)[XB_TMO])) break; if (_sp > XB_SPIN_CAP) { atomicAdd(&(bar)[XB_TMO], 1u); break; } } } } while (0)
struct XcdBarrier { unsigned* bar; unsigned x; volatile LAS unsigned* st; };
__device__ __forceinline__ XcdBarrier xcd_barrier_post(unsigned* bar, volatile LAS unsigned* st, const int wave_s) {
    XcdBarrier b; b.bar = bar; b.x = xb_xcc_id(); b.st = st;
    if (phase_tid(wave_s) == 0) (void)xb_add(&bar[XB_XCNT(b.x)], 1u);
    return b;
}
__device__ __forceinline__ void xcd_barrier_complete(unsigned* bar, unsigned x, unsigned& nloc, unsigned& nx) {
    const unsigned G = gridDim.x * gridDim.y * gridDim.z;
    unsigned sum, cnt, mine, sp = 0u;
    for (;;) {
        sum = 0u; cnt = 0u; mine = 0u;
#pragma unroll
        for (unsigned j = 0; j < 16; ++j) { const unsigned c = xb_ld(&bar[XB_XCNT(j)]); sum += c; cnt += (c > 0u) ? 1u : 0u; mine = (j == x) ? c : mine; }
        if (sum == G) break;
        __builtin_amdgcn_s_sleep(1);
        if ((++sp & 255u) == 0u) { if (xb_ld(&bar[XB_TMO])) break; if (sp > XB_SPIN_CAP) { atomicAdd(&bar[XB_TMO], 1u); break; } }
    }
    nloc = mine > 0u ? mine : 1u; nx = cnt > 0u ? cnt : 1u;
}
__device__ __forceinline__ void xcd_barrier(const XcdBarrier& b, const int wave_s) {
    asm volatile("s_waitcnt vmcnt(0)" ::: "memory");
    __syncthreads();
    if (phase_tid(wave_s) == 0) {
        unsigned* bar = b.bar;
        __builtin_amdgcn_s_waitcnt(0);
        unsigned nloc = b.st[0], nx = b.st[1];
        if (nloc == 0u) { xcd_barrier_complete(bar, b.x, nloc, nx); b.st[0] = nloc; b.st[1] = nx; }
        const unsigned old = xb_add(&bar[XB_XSUB(b.x)], 1u);
        const unsigned gen = old / nloc;
        if (old + 1u == (gen + 1u) * nloc) {
            __builtin_amdgcn_fence(__ATOMIC_RELEASE, "agent");
            asm volatile("s_waitcnt vmcnt(0)" ::: "memory");
            const unsigned og = xb_add(&bar[XB_TOP], 1u);
            const unsigned tg = og / nx;
            if (og + 1u == (tg + 1u) * nx) xb_add(&bar[XB_TOPGEN], 1u);
            else XB_SPIN(xb_ld(&bar[XB_TOPGEN]) == tg, bar);
            __builtin_amdgcn_fence(__ATOMIC_ACQUIRE, "agent");
            xb_add(&bar[XB_XGEN(b.x)], 1u);
            asm volatile("s_waitcnt vmcnt(0)" ::: "memory");
        } else {
            XB_SPIN(xb_ld(&bar[XB_XGEN(b.x)]) == gen, bar);
            __builtin_amdgcn_fence(__ATOMIC_ACQUIRE, "agent");
            asm volatile("s_waitcnt vmcnt(0)" ::: "memory");
        }
    }
    __syncthreads();
}

constexpr int BM = 256, BK = 64, HALF = 128, HTB = HALF * BK * 2, STAGE_BYTES = 8 * HTB, NXCD = 8, WGM = 4;
__device__ __forceinline__ int lds_byte(int r, int c) { const int st = (r >> 4) * 2 + (c >> 5), rr = r & 15, cc = c & 31, ob = rr * 64 + cc * 2; return st * 1024 + (ob ^ (((ob >> 9) & 1) << 5)); }
__device__ __forceinline__ void stage_rc(int b, int& R, int& C) { const int st = b / 1024, sb = b % 1024, swz = sb ^ (((sb >> 9) & 1) << 5); R = (st >> 1) * 16 + swz / 64; C = (st & 1) * 32 + (swz % 64) / 2; }
__device__ __forceinline__ int perm32(int rho) { const int n = rho >> 4, i = rho & 15; return 8 * (i >> 2) + 4 * n + (i & 3); }

struct Unit { int pm, pn; };
struct Gemm { const bf16_t* A; const bf16_t* Bt; int lda, ldb, K, a_pn_off; };

struct StaticOrder {
    int nM, nN, nwg, G, c;
    __device__ __forceinline__ void init(int nM_, int nN_, int G_, int c_) { nM = nM_; nN = nN_; nwg = nM * nN; G = G_; c = c_; }
    __device__ __forceinline__ bool next(int i, Unit& u) const {
        const long Lx = (long)i * G + c; if (Lx >= nwg) return false;
        int wgid = (int)Lx; { const int q = nwg / NXCD, r = nwg % NXCD, xcd = wgid % NXCD, off = wgid / NXCD; wgid = (xcd < r ? xcd * (q + 1) : r * (q + 1) + (xcd - r) * q) + off; }
        const int nig = WGM * nN, gid = wgid / nig, fm = gid * WGM, gsz = (nM - fm) < WGM ? (nM - fm) : WGM;
        u.pm = fm + ((wgid % nig) % gsz); u.pn = (wgid % nig) / gsz; return true;
    }
};

template <class Epi>
__device__ __forceinline__ void gemm_phase(LAS unsigned char* lds, const Gemm g, const StaticOrder& S, const Epi& E, const int wave_s) {
    int tid_ = phase_tid(wave_s);
    const int tid = tid_, wid = __builtin_amdgcn_readfirstlane(tid >> 6), lane = tid & 63, wr = wid >> 2, wc = wid & 3, fr = lane & 15, fq = lane >> 4;
    const int K = g.K, nt = K / BK;
    unsigned voffA[2], voffB[2];
#pragma unroll
    for (int i = 0; i < 2; ++i) { int R, C; stage_rc(tid * 16 + i * 8192, R, C); const int Rb = (R & ~31) + perm32(R & 31);
        voffA[i] = (unsigned)(R * g.lda + C) * 2u; voffB[i] = (unsigned)(Rb * g.ldb + C) * 2u; }
    const size_t kstep = (size_t)(BK * 2);
    const size_t hstepA = (size_t)HALF * g.lda * 2, hstepB = (size_t)HALF * g.ldb * 2;
    const size_t tstepA = 2 * hstepA, tstepB = 2 * hstepB;
    const unsigned ldsw = (unsigned)wid * 1024u;
    const int aoff = lds_byte(wr * 64 + fr, fq * 8), boff = lds_byte(wc * 32 + fr, fq * 8);
#define PG8_SA(b, h) (((b) * 2 + (h)) * HTB)
#define PG8_SB(b, h) ((4 + (b) * 2 + (h)) * HTB)
#define PG8_STAGE(bufoff, gbase, voff) do { _Pragma("unroll") for (int _i = 0; _i < 2; ++_i) \
        __builtin_amdgcn_global_load_lds((const unsigned*)((const char*)(gbase) + (voff)[_i]), (LAS unsigned*)(lds + (bufoff) + ldsw + _i * 8192), 16, 0, 0); } while (0)
#define PG8_LDA(dst, b, h) do { _Pragma("unroll") for (int m = 0; m < 4; ++m) _Pragma("unroll") for (int k = 0; k < 2; ++k) dst[m][k] = *(const LAS bf16x8*)(lds + PG8_SA(b, h) + aoff + m * 2048 + k * 1024); } while (0)
#define PG8_LDB(dst, b, h) do { _Pragma("unroll") for (int n = 0; n < 2; ++n) _Pragma("unroll") for (int k = 0; k < 2; ++k) dst[n][k] = *(const LAS bf16x8*)(lds + PG8_SB(b, h) + boff + n * 2048 + k * 1024); } while (0)
#define PG8_MMA(ai, bj, At, Bt) do { __builtin_amdgcn_s_setprio(1); _Pragma("unroll") for (int m = 0; m < 4; ++m) _Pragma("unroll") for (int n = 0; n < 2; ++n) _Pragma("unroll") for (int k = 0; k < 2; ++k) \
        acc[ai][bj][m][n] = __builtin_amdgcn_mfma_f32_16x16x32_bf16(Bt[n][k], At[m][k], acc[ai][bj][m][n], 0, 0, 0); __builtin_amdgcn_s_setprio(0); } while (0)
#define PG8_WAIT_V(n) asm volatile("s_waitcnt vmcnt(" #n ")" ::: "memory")
#define PG8_WAIT_L(n) asm volatile("s_waitcnt lgkmcnt(" #n ")" ::: "memory")
#define PG8_BAR __builtin_amdgcn_s_barrier()
#define PG8_SCHED __builtin_amdgcn_sched_barrier(0)
    Unit cur, nxt; int ui = 0;
    if (!S.next(0, cur)) return;
    f32x4 acc[2][2][4][2];
#pragma unroll
    for (int a = 0; a < 2; ++a)
#pragma unroll
        for (int b = 0; b < 2; ++b)
#pragma unroll
            for (int m = 0; m < 4; ++m)
#pragma unroll
                for (int n = 0; n < 2; ++n) acc[a][b][m][n] = (f32x4){0.f, 0.f, 0.f, 0.f};
    bf16x8 At[4][2], B0[2][2], B1[2][2];
    float rsv[8];
#pragma unroll
    for (int i = 0; i < 8; ++i) rsv[i] = 0.f;
    const char* cA = (const char*)g.A + (size_t)cur.pm * tstepA + (size_t)cur.pn * g.a_pn_off; const char* cB = (const char*)g.Bt + (size_t)cur.pn * tstepB;
    PG8_STAGE(PG8_SB(0, 0), cB, voffB); PG8_STAGE(PG8_SA(0, 0), cA, voffA); PG8_STAGE(PG8_SB(0, 1), cB + hstepB, voffB); PG8_STAGE(PG8_SA(0, 1), cA + hstepA, voffA);
    if (wr == 1) PG8_BAR;
    PG8_WAIT_V(4); PG8_BAR;
    PG8_STAGE(PG8_SB(1, 0), cB + kstep, voffB); PG8_STAGE(PG8_SA(1, 0), cA + kstep, voffA); PG8_STAGE(PG8_SB(1, 1), cB + hstepB + kstep, voffB);
    PG8_WAIT_V(6); PG8_BAR;
    for (;;) {
        const bool has_next = S.next(ui + 1, nxt);
        const char* nA = has_next ? (const char*)g.A + (size_t)nxt.pm * tstepA + (size_t)nxt.pn * g.a_pn_off : cA; const char* nB = has_next ? (const char*)g.Bt + (size_t)nxt.pn * tstepB : cB;
        for (int t = 0; t < nt; t += 2) {
            const bool last = (t == nt - 2);
            const char* a1 = cA + (size_t)(t + 1) * kstep;
            const char* a2 = last ? nA : cA + (size_t)(t + 2) * kstep; const char* b2 = last ? nB : cB + (size_t)(t + 2) * kstep;
            const char* a3 = a2 + kstep; const char* b3 = b2 + kstep;
            if (last) E.prefetch(cur, wr, fr, rsv);
            PG8_LDB(B0, 0, 0); PG8_SCHED; PG8_LDA(At, 0, 0); PG8_STAGE(PG8_SA(1, 1), a1 + hstepA, voffA);
            PG8_WAIT_L(8); PG8_BAR; PG8_WAIT_L(0); PG8_MMA(0, 0, At, B0); PG8_BAR; PG8_SCHED;
            PG8_LDB(B1, 0, 1); PG8_STAGE(PG8_SB(0, 0), b2, voffB);
            PG8_BAR; PG8_WAIT_L(0); PG8_MMA(0, 1, At, B1); PG8_BAR;
            PG8_LDA(At, 0, 1); PG8_STAGE(PG8_SA(0, 0), a2, voffA);
            PG8_BAR; PG8_WAIT_L(0); PG8_MMA(1, 0, At, B0); PG8_BAR; PG8_SCHED;
            PG8_STAGE(PG8_SB(0, 1), b2 + hstepB, voffB);
            PG8_WAIT_V(6); PG8_BAR; PG8_MMA(1, 1, At, B1); PG8_BAR;
            PG8_LDB(B0, 1, 0); PG8_SCHED; PG8_LDA(At, 1, 0); PG8_STAGE(PG8_SA(0, 1), a2 + hstepA, voffA);
            PG8_WAIT_L(8); PG8_BAR; PG8_WAIT_L(0); PG8_MMA(0, 0, At, B0); PG8_BAR; PG8_SCHED;
            PG8_LDB(B1, 1, 1); PG8_STAGE(PG8_SB(1, 0), b3, voffB);
            PG8_BAR; PG8_WAIT_L(0); PG8_MMA(0, 1, At, B1); PG8_BAR;
            PG8_LDA(At, 1, 1); PG8_STAGE(PG8_SA(1, 0), a3, voffA);
            PG8_BAR; PG8_WAIT_L(0); PG8_MMA(1, 0, At, B0); PG8_BAR; PG8_SCHED;
            PG8_STAGE(PG8_SB(1, 1), b3 + hstepB, voffB);
            PG8_WAIT_V(6); PG8_BAR; PG8_MMA(1, 1, At, B1); PG8_BAR;
        }
        E(acc, cur, wr, wc, fr, fq, rsv);
        if (!has_next) break;
#pragma unroll
        for (int a = 0; a < 2; ++a)
#pragma unroll
            for (int b = 0; b < 2; ++b)
#pragma unroll
                for (int m = 0; m < 4; ++m)
#pragma unroll
                    for (int n = 0; n < 2; ++n) acc[a][b][m][n] = (f32x4){0.f, 0.f, 0.f, 0.f};
        cur = nxt; cA = nA; cB = nB; ++ui;
    }
    PG8_WAIT_V(0);
    if (wr == 0) PG8_BAR;
    PG8_BAR;
#undef PG8_SA
#undef PG8_SB
#undef PG8_STAGE
#undef PG8_LDA
#undef PG8_LDB
#undef PG8_MMA
#undef PG8_WAIT_V
#undef PG8_WAIT_L
#undef PG8_BAR
#undef PG8_SCHED
}

__device__ __forceinline__ float silu_mul(float g, float u) { return g * __builtin_amdgcn_rcpf(1.0f + __expf(-g)) * u; }

struct EpiSwiGLU {
    const float* ssq; bf16_t* act;
    __device__ __forceinline__ void prefetch(const Unit& u, int wr, int fr, float (&rsv)[8]) const {
#pragma unroll
        for (int ai = 0; ai < 2; ++ai)
#pragma unroll
            for (int m = 0; m < 4; ++m) rsv[ai * 4 + m] = ssq[u.pm * BM + wr * 64 + fr + ai * HALF + m * 16]; }
    __device__ __forceinline__ void operator()(const f32x4 (&acc)[2][2][4][2], const Unit& u, int wr, int wc, int fr, int fq, const float (&rsv)[8]) const {
        const int row0 = u.pm * BM + wr * 64 + fr, col0 = u.pn * 128 + wc * 32 + 8 * fq;
#pragma unroll
        for (int ai = 0; ai < 2; ++ai)
#pragma unroll
            for (int m = 0; m < 4; ++m) {
                const int row = row0 + ai * HALF + m * 16;
                {
                    const float rs = rsqrtf(rsv[ai * 4 + m] * (1.0f / D) + EPS), c1 = rs * -1.4426950408889634f, r2 = rs * rs;
                    u32x4 o;
#pragma unroll
                    for (int n = 0; n < 2; ++n) {
                        const f32x4 ga = acc[ai][0][m][n], ua = acc[ai][1][m][n];
                        const f32x4 t = ga * c1;
                        f32x4 d = {__builtin_amdgcn_exp2f(t[0]), __builtin_amdgcn_exp2f(t[1]), __builtin_amdgcn_exp2f(t[2]), __builtin_amdgcn_exp2f(t[3])};
                        d = d + 1.0f;
                        f32x4 r = {__builtin_amdgcn_rcpf(d[0]), __builtin_amdgcn_rcpf(d[1]), __builtin_amdgcn_rcpf(d[2]), __builtin_amdgcn_rcpf(d[3])};
                        const f32x4 v = (ga * ua) * (r * r2);
                        o[2 * n] = cvt_pk_bf16(v[0], v[1]); o[2 * n + 1] = cvt_pk_bf16(v[2], v[3]);
                    }
                    *(u32x4*)(act + (size_t)row * DFF + col0) = o;
                }
            }
    }
};

template <int MODE> struct EpiRes {
    const float* x; const float* meta; float* out; float* hmeta; bf16_t* hb; float* ssq;
    __device__ __forceinline__ void prefetch(const Unit&, int, int, float (&)[8]) const {}
    __device__ __forceinline__ void operator()(const f32x4 (&acc)[2][2][4][2], const Unit& u, int wr, int wc, int fr, int fq, const float (&rsv)[8]) const {
        const int row0 = u.pm * BM + wr * 64 + fr, col0 = u.pn * BM + wc * 32 + 8 * fq;
        const float fac = (MODE == 6) ? 1.0f : 0.5f;
#pragma unroll
        for (int ai = 0; ai < 2; ++ai) {
            f32x4 r[(MODE == 2) ? 4 : 1][2][2]; u32x4 hr[(MODE == 2) ? 1 : 4][2];
#pragma unroll
            for (int m = 0; m < 4; ++m)
#pragma unroll
                for (int bj = 0; bj < 2; ++bj) { const size_t off = (size_t)(row0 + ai * HALF + m * 16) * D + col0 + bj * HALF;
                    if (MODE == 2) { r[m][bj][0] = __builtin_nontemporal_load((const f32x4*)(x + off)); r[m][bj][1] = __builtin_nontemporal_load((const f32x4*)(x + off + 4)); }
                    else hr[m][bj] = __builtin_nontemporal_load((const u32x4*)(hb + off)); }
#pragma unroll
            for (int m = 0; m < 4; ++m) {
                const int row = row0 + ai * HALF + m * 16;
                float ss = 0.f;
#pragma unroll
                for (int bj = 0; bj < 2; ++bj) {
                    const int c = col0 + bj * HALF;
                    f32x4 r0, r1;
                    if (MODE == 2) { r0 = r[m][bj][0]; r1 = r[m][bj][1]; }
                    else { const u32x4 h = hr[m][bj]; r0 = (f32x4){bf_lo(h[0]), bf_hi(h[0]), bf_lo(h[1]), bf_hi(h[1])}; r1 = (f32x4){bf_lo(h[2]), bf_hi(h[2]), bf_lo(h[3]), bf_hi(h[3])}; }
                    const f32x4 v0 = r0 + acc[ai][bj][m][0] * fac, v1 = r1 + acc[ai][bj][m][1] * fac;
                    if (MODE == 8) { float* orow = out + (size_t)row * D; __builtin_nontemporal_store(v0, (f32x4*)(orow + c)); __builtin_nontemporal_store(v1, (f32x4*)(orow + c + 4)); }
                    else {
                        u32x4 o; o[0] = cvt_pk_bf16(v0[0], v0[1]); o[1] = cvt_pk_bf16(v0[2], v0[3]); o[2] = cvt_pk_bf16(v1[0], v1[1]); o[3] = cvt_pk_bf16(v1[2], v1[3]);
                        *(u32x4*)(hb + (size_t)row * D + c) = o;
                        ss += v0[0] * v0[0] + v0[1] * v0[1] + v0[2] * v0[2] + v0[3] * v0[3] + v1[0] * v1[0] + v1[1] * v1[1] + v1[2] * v1[2] + v1[3] * v1[3];
                    }
                }
                if (MODE != 8) { ss = xsum16_32(ss); if (fq == 0) atomicAdd(ssq + row, ss); }
            }
        }
    }
};

struct EpiZ {
    const float* ssq; bf16_t* z; float* flog; float* ssqqk;
    __device__ __forceinline__ void prefetch(const Unit& u, int wr, int fr, float (&rsv)[8]) const {
#pragma unroll
        for (int ai = 0; ai < 2; ++ai)
#pragma unroll
            for (int m = 0; m < 4; ++m) rsv[ai * 4 + m] = ssq[u.pm * BM + wr * 64 + fr + ai * HALF + m * 16]; }
    __device__ __forceinline__ void operator()(const f32x4 (&acc)[2][2][4][2], const Unit& u, int wr, int wc, int fr, int fq, const float (&rsv)[8]) const {
        const int row0 = u.pm * BM + wr * 64 + fr, col0 = u.pn * BM + wc * 32 + 8 * fq, pn = u.pn;
#pragma unroll
        for (int ai = 0; ai < 2; ++ai)
#pragma unroll
            for (int m = 0; m < 4; ++m) {
                const int row = row0 + ai * HALF + m * 16;
                const bool ok = row < M;
                const float rs = ok ? rsqrtf(rsv[ai * 4 + m] * (1.0f / D) + EPS) : 0.f;
                if (pn < 16) {
#pragma unroll
                    for (int bj = 0; bj < 2; ++bj) {
                        const f32x4 v0 = acc[ai][bj][m][0] * rs, v1 = acc[ai][bj][m][1] * rs;
                        if (ok) { u32x4 o; o[0] = cvt_pk_bf16(v0[0], v0[1]); o[1] = cvt_pk_bf16(v0[2], v0[3]); o[2] = cvt_pk_bf16(v1[0], v1[1]); o[3] = cvt_pk_bf16(v1[2], v1[3]);
                            *(u32x4*)(z + (size_t)row * ZW + col0 + bj * HALF) = o; }
                        if (pn >= 4 && pn < 12) {
                            float ss = v0[0] * v0[0] + v0[1] * v0[1] + v0[2] * v0[2] + v0[3] * v0[3] + v1[0] * v1[0] + v1[1] * v1[1] + v1[2] * v1[2] + v1[3] * v1[3];
                            ss = xsum16_32(ss);
                            if (fq == 0 && ok) ssqqk[(size_t)row * 64 + ((pn - 4) * 2 + bj) * 4 + wc] = ss;
                        }
                    }
                } else if (wc == 0 && fq == 0 && ok) {
                    *(f32x4*)(flog + (size_t)row * 8) = acc[ai][0][m][0] * rs; *(f32x4*)(flog + (size_t)row * 8 + 4) = acc[ai][0][m][1] * rs;
                }
            }
    }
};

struct EpiPlain {
    bf16_t* O;
    __device__ __forceinline__ void prefetch(const Unit&, int, int, float (&)[8]) const {}
    __device__ __forceinline__ void operator()(const f32x4 (&acc)[2][2][4][2], const Unit& u, int wr, int wc, int fr, int fq, const float (&rsv)[8]) const {
        const int row0 = u.pm * BM + wr * 64 + fr, col0 = u.pn * BM + wc * 32 + 8 * fq;
#pragma unroll
        for (int ai = 0; ai < 2; ++ai)
#pragma unroll
            for (int m = 0; m < 4; ++m) {
                const int row = row0 + ai * HALF + m * 16;
                if (row < M) {
#pragma unroll
                    for (int bj = 0; bj < 2; ++bj) {
                        const f32x4 v0 = acc[ai][bj][m][0], v1 = acc[ai][bj][m][1];
                        u32x4 o; o[0] = cvt_pk_bf16(v0[0], v0[1]); o[1] = cvt_pk_bf16(v0[2], v0[3]); o[2] = cvt_pk_bf16(v1[0], v1[1]); o[3] = cvt_pk_bf16(v1[2], v1[3]);
                        *(u32x4*)(O + (size_t)row * D + col0 + bj * HALF) = o;
                    }
                }
            }
    }
};

template <int MODE, int KSTEPS, int UNR>
__device__ __forceinline__ void skinny_phase(const Params& p, unsigned char* shm, int ctr_idx, int ntasks, const int wave_s) {
    unsigned char* ws = p.ws;
    int tid_ = phase_tid(wave_s);
    const int tid = tid_, wid = tid >> 6, lane = tid & 63, fr = lane & 15, quad = lane >> 4;
    f32x4* part = (f32x4*)shm;
    int* taskp = (int*)(shm + 16384);
    int* ctr = (int*)(ws + WS_CTR) + ctr_idx;
    const bf16_t* A = (MODE == 2) ? (const bf16_t*)(ws + WS_ACT) + (size_t)MX * DFF : (const bf16_t*)(ws + WS_HB) + (size_t)MX * D;
    const bf16_t* Bt = (const bf16_t*)(ws + (MODE == 1 ? WS_GU1 : MODE == 2 ? WS_D1 : WS_IN));
    constexpr int LDK = (MODE == 2) ? DFF : D;
    for (;;) {
        __syncthreads();
        if (tid == 0) *taskp = atomicAdd(ctr, 1);
        __syncthreads();
        const int cb = *taskp;
        if (cb >= ntasks) break;
        const int kbase = wid * KSTEPS * 32 + quad * 8;
        const bf16_t* ap = A + (size_t)fr * LDK + kbase;
        const int brow = (MODE == 1) ? ((cb >> 3) * 256 + (cb & 7) * 16 + fr) : cb * 16 + fr;
        const bf16_t* bp = Bt + (size_t)brow * LDK + kbase;
        f32x4 acc0 = {0.f, 0.f, 0.f, 0.f}, acc1 = {0.f, 0.f, 0.f, 0.f};
        for (int s0 = 0; s0 < KSTEPS; s0 += UNR) {
            bf16x8 av[UNR], b0[UNR], b1[UNR];
#pragma unroll
            for (int u = 0; u < UNR; ++u) { av[u] = *(const bf16x8*)(ap + (s0 + u) * 32); b0[u] = *(const bf16x8*)(bp + (s0 + u) * 32);
                if (MODE == 1) b1[u] = *(const bf16x8*)(bp + (size_t)128 * LDK + (s0 + u) * 32); }
#pragma unroll
            for (int u = 0; u < UNR; ++u) { acc0 = __builtin_amdgcn_mfma_f32_16x16x32_bf16(b0[u], av[u], acc0, 0, 0, 0);
                if (MODE == 1) acc1 = __builtin_amdgcn_mfma_f32_16x16x32_bf16(b1[u], av[u], acc1, 0, 0, 0); }
        }
        part[wid * 64 + lane] = acc0;
        if (MODE == 1) part[512 + wid * 64 + lane] = acc1;
        __syncthreads();
        if (wid == 0) {
            f32x4 a0 = part[lane], a1 = {0.f, 0.f, 0.f, 0.f};
#pragma unroll
            for (int w = 1; w < 8; ++w) a0 += part[w * 64 + lane];
            if (MODE == 1) { a1 = part[512 + lane];
#pragma unroll
                for (int w = 1; w < 8; ++w) a1 += part[512 + w * 64 + lane]; }
            const int row = MX + fr, c = cb * 16 + quad * 4;
            if (MODE == 1) {
                const float rs = rsqrtf(((const float*)(ws + WS_SSQ0))[row] * (1.0f / D) + EPS);
                u32x2 o; o[0] = cvt_pk_bf16(silu_mul(a0[0] * rs, a1[0] * rs), silu_mul(a0[1] * rs, a1[1] * rs)); o[1] = cvt_pk_bf16(silu_mul(a0[2] * rs, a1[2] * rs), silu_mul(a0[3] * rs, a1[3] * rs));
                *(u32x2*)((bf16_t*)(ws + WS_ACT) + (size_t)row * DFF + c) = o;
            } else if (MODE == 2) {
                const f32x4 v = *(const f32x4*)(p.in[1] + (size_t)fr * D + c) + a0 * 0.5f;
                *(f32x4*)((float*)(ws + WS_HMETA) + (size_t)fr * D + c) = v;
                u32x2 o; o[0] = cvt_pk_bf16(v[0], v[1]); o[1] = cvt_pk_bf16(v[2], v[3]);
                *(u32x2*)((bf16_t*)(ws + WS_HB) + (size_t)row * D + c) = o;
                float ss = v[0] * v[0] + v[1] * v[1] + v[2] * v[2] + v[3] * v[3];
                ss = xsum16_32(ss);
                if (quad == 0) atomicAdd((float*)(ws + WS_SSQ1) + row, ss);
            } else {
                const float rs = rsqrtf(((const float*)(ws + WS_SSQ1))[row] * (1.0f / D) + EPS);
                const f32x4 v = a0 * rs;
                if (cb < 256) {
                    u32x2 o; o[0] = cvt_pk_bf16(v[0], v[1]); o[1] = cvt_pk_bf16(v[2], v[3]);
                    *(u32x2*)((bf16_t*)(ws + WS_Z) + (size_t)row * ZW + c) = o;
                    if (cb >= 64 && cb < 192) {
                        float ss = v[0] * v[0] + v[1] * v[1] + v[2] * v[2] + v[3] * v[3];
                        ss = xsum16_32(ss);
                        if (quad == 0) atomicAdd((float*)(ws + WS_SSQQK) + (size_t)row * 64 + ((cb - 64) >> 3) * 4, ss);
                    }
                } else if (quad < 2) *(f32x4*)((float*)(ws + WS_FLOG) + (size_t)row * 8 + quad * 4) = v;
            }
        }
    }
}

struct TileDesc { const float* src; const float* gk; const float* sn; bf16_t* dst; int ldn, nvalid, k0, n0, dstK, drow0; };
constexpr int CT_LDB = 288  , CT_SLOT = 128 * CT_LDB;
__device__ __forceinline__ TileDesc cvt_decode(const Params& p, int ti) {
    constexpr int T_FF = 704, T_IN = 16 * 33, T_OUT = 16 * 16;
    unsigned char* ws = p.ws;
    TileDesc d; d.gk = nullptr; d.sn = nullptr;
    if (ti < 6 * T_FF) {
        const int job = ti / T_FF, r = ti - job * T_FF, layer = job / 3, kind = job - layer * 3;
        if (kind < 2) {
            const int tk = r / 44, tn = r - tk * 44;
            d.src = p.in[(layer ? 15 : 3) + kind]; d.dst = (bf16_t*)(ws + (layer ? WS_GU2 : WS_GU1)); d.gk = p.in[layer ? 14 : 2];
            d.ldn = DFF; d.nvalid = DFF; d.k0 = tk * 128; d.n0 = tn * 128; d.dstK = D; d.drow0 = tn * 256 + kind * 128;
        } else {
            const int tk = r / 16, tn = r - tk * 16;
            d.src = p.in[layer ? 17 : 5]; d.dst = (bf16_t*)(ws + (layer ? WS_D2 : WS_D1));
            d.ldn = D; d.nvalid = D; d.k0 = tk * 128; d.n0 = tn * 128; d.dstK = DFF; d.drow0 = tn * 128;
        }
    } else if (ti < 6 * T_FF + T_IN) {
        const int r = ti - 6 * T_FF, tk = r / 33, tn = r - tk * 33;
        d.src = p.in[7]; d.dst = (bf16_t*)(ws + WS_IN); d.gk = p.in[6];
        d.ldn = DIN; d.nvalid = DIN; d.k0 = tk * 128; d.n0 = tn * 128; d.dstK = D; d.drow0 = tn * 128;
    } else if (ti < 6 * T_FF + T_IN + T_OUT) {
        const int r = ti - 6 * T_FF - T_IN, tk = r >> 4, tn = r & 15;
        d.src = p.in[13]; d.dst = (bf16_t*)(ws + WS_OUT);
        d.ldn = D; d.nvalid = D; d.k0 = tk * 128; d.n0 = tn * 128; d.dstK = D; d.drow0 = tn * 128;
    } else {
        const int r = ti - 6 * T_FF - T_IN - T_OUT, g = r >> 2, tk = (r >> 1) & 1, tn = r & 1;
        d.src = p.in[11] + (size_t)g * 65536; d.dst = (bf16_t*)(ws + WS_POOL) + (size_t)g * 65536; d.sn = p.in[12] + g * 256;
        d.ldn = 256; d.nvalid = 256; d.k0 = tk * 128; d.n0 = tn * 128; d.dstK = 256; d.drow0 = tn * 128;
    }
    return d;
}
#define CVT_LOAD(d, v, gv) do { _Pragma("unroll") for (int _i = 0; _i < 8; ++_i) { const int idx = tid + _i * 512, k = idx >> 5, n = (d).n0 + (idx & 31) * 4; \
        v[_i] = (n < (d).nvalid) ? __builtin_nontemporal_load((const f32x4*)((d).src + (size_t)((d).k0 + k) * (d).ldn + n)) : (f32x4){0.f, 0.f, 0.f, 0.f};        \
        gv[_i] = (d).gk ? (d).gk[(d).k0 + k] : 1.0f; } } while (0)
#define CVT_PROCESS(cur, v, gv, MID) do { \
        _Pragma("unroll") for (int i = 0; i < 8; ++i) { const int idx = tid + i * 512, k = idx >> 5, n4 = idx & 31; \
            f32x4 sc = {1.f, 1.f, 1.f, 1.f}; if ((cur).sn) sc = *(const f32x4*)((cur).sn + (cur).n0 + n4 * 4); \
            const float g = gv[i]; u32x2 o; o[0] = cvt_pk_bf16(v[i][0] * g * sc[0], v[i][1] * g * sc[1]); o[1] = cvt_pk_bf16(v[i][2] * g * sc[2], v[i][3] * g * sc[3]); \
            *(u32x2*)(tile + k * CT_LDB + ((n4 * 8) ^ (((k >> 3) & 1) << 7))) = o; } \
        LDS_BARRIER(); \
        MID; \
        { const int w_ = tid >> 6, q_ = (tid >> 4) & 3, i_ = tid & 15; \
          _Pragma("unroll") for (int j = 0; j < 4; ++j) { const int kc = 4 * j + q_, kr = kc * 8 + (i_ >> 2); \
            LAS unsigned char* tp = (LAS unsigned char*)tile + kr * CT_LDB + ((32 * w_ + 8 * (i_ & 3)) ^ ((kc & 1) << 7)); \
            const s16x4 a = __builtin_amdgcn_ds_read_tr16_b64_v4i16((LAS s16x4*)tp), b = __builtin_amdgcn_ds_read_tr16_b64_v4i16((LAS s16x4*)(tp + 4 * CT_LDB)); \
            const bf16x8 o = {a[0], a[1], a[2], a[3], b[0], b[1], b[2], b[3]}; \
            *(bf16x8*)((cur).dst + (size_t)((cur).drow0 + 16 * w_ + i_) * (cur).dstK + (cur).k0 + kc * 8) = o; } } \
        LDS_BARRIER(); } while (0)

__device__ __forceinline__ void prep_phase(const Params& p, unsigned char* shm, const int wave_s) {
    unsigned char* tile = shm;
    unsigned char* ws = p.ws;
    int tid_ = phase_tid(wave_s);
    const int tid = tid_, wid = tid >> 6, lane = tid & 63;
    constexpr int T_ALL = 3 * 704;
    int ti = blockIdx.x;
    TileDesc cur = cvt_decode(p, ti);
    f32x4 v[8]; float gv[8];
    CVT_LOAD(cur, v, gv);
    { float* s1 = (float*)(ws + WS_SSQ1); float* s2 = (float*)(ws + WS_SSQ2); float* sq = (float*)(ws + WS_SSQQK);
      const int gt = blockIdx.x * 512 + tid, nth = gridDim.x * 512;
      for (int i = gt; i < MP; i += nth) { s1[i] = 0.f; s2[i] = 0.f; }
      for (int i = gt; i < (MX + NMETA) * 64; i += nth) sq[i] = 0.f;
      if (gt < 8) ((int*)(ws + WS_CTR))[gt] = 0; }
    { bf16_t* hb = (bf16_t*)(ws + WS_HB); float* ssq0 = (float*)(ws + WS_SSQ0);
      for (int row = blockIdx.x * 8 + wid; row < M; row += gridDim.x * 8) {
          const float* src = (row >= MX) ? p.in[1] + (size_t)(row - MX) * D : p.in[0] + (size_t)row * D;
          float ss = 0.f;
#pragma unroll
          for (int i = 0; i < 8; ++i) { const int c = i * 256 + lane * 4; const f32x4 x4 = __builtin_nontemporal_load((const f32x4*)(src + c));
              ss += x4[0] * x4[0] + x4[1] * x4[1] + x4[2] * x4[2] + x4[3] * x4[3];
              u32x2 o; o[0] = cvt_pk_bf16(x4[0], x4[1]); o[1] = cvt_pk_bf16(x4[2], x4[3]); *(u32x2*)(hb + (size_t)row * D + c) = o; }
          ss += __shfl_xor(ss, 1); ss += __shfl_xor(ss, 2); ss += __shfl_xor(ss, 4); ss += __shfl_xor(ss, 8); ss += __shfl_xor(ss, 16); ss += __shfl_xor(ss, 32);
          if (lane == 0) ssq0[row] = ss;
      } }
    for (;;) {
        const int tn_ = ti + gridDim.x; const bool has_next = tn_ < T_ALL;
        TileDesc nx = cur; f32x4 vn[8]; float gn[8];
        if (has_next) { nx = cvt_decode(p, tn_); CVT_LOAD(nx, vn, gn); }
        CVT_PROCESS(cur, v, gv, (void)0);
        if (!has_next) break;
        cur = nx; ti = tn_;
#pragma unroll
        for (int i = 0; i < 8; ++i) { v[i] = vn[i]; gv[i] = gn[i]; }
    }
}

template <int WHICH> __device__ __forceinline__ int cvt_qmap(int n) {
    if (WHICH == 0) return n < 800 ? 4224 + n : 2112 + (n - 800);
    return 3520 + n;
}
template <int WHICH> __device__ __forceinline__ void cvt_queue(const Params& p, unsigned char* shm, int ctr_idx, int count, const int wave_s) {
    unsigned char* tile = shm;
    volatile int* slot = (volatile int*)(shm + CT_SLOT);
    int* ctr = (int*)(p.ws + WS_CTR) + ctr_idx;
    int tid_ = phase_tid(wave_s);
    const int tid = tid_;
    __syncthreads();
    if (tid == 0) { slot[0] = atomicAdd(ctr, 1); slot[1] = atomicAdd(ctr, 1); }
    __syncthreads();
    int n_cur = slot[0], n_nxt = slot[1];
    if (n_cur >= count) return;
    TileDesc cur = cvt_decode(p, cvt_qmap<WHICH>(n_cur));
    f32x4 v[8]; float gv[8];
    CVT_LOAD(cur, v, gv);
    for (;;) {
        const bool has_next = n_nxt < count;
        TileDesc nx = cur; f32x4 vn[8]; float gn[8];
        if (has_next) { nx = cvt_decode(p, cvt_qmap<WHICH>(n_nxt)); CVT_LOAD(nx, vn, gn); }
        if (tid == 0) slot[2] = atomicAdd(ctr, 1);
        int n_after = 0;
        CVT_PROCESS(cur, v, gv, n_after = slot[2]);
        if (!has_next) break;
        cur = nx; n_nxt = n_after;
#pragma unroll
        for (int i = 0; i < 8; ++i) { v[i] = vn[i]; gv[i] = gn[i]; }
    }
}

__device__ __forceinline__ void flog_phase(const Params& p, unsigned char* shm, const int wave_s) {
    unsigned char* ws = p.ws;
    int tid_ = phase_tid(wave_s);
    const int tid = tid_, wid = tid >> 6, lane = tid & 63, fr = lane & 15, quad = lane >> 4;
    f32x4* part = (f32x4*)shm;
    for (int t2 = blockIdx.x; t2 < 256; t2 += gridDim.x) {
        const int task = t2 * 2 + (wid >> 2), kq = wid & 3;
        const bf16_t* hp = (const bf16_t*)(ws + WS_HB) + (size_t)(task * 16 + fr) * D + kq * 512 + quad * 8;
        const bf16_t* wp = (const bf16_t*)(ws + WS_IN) + (size_t)(4096 + fr) * D + kq * 512 + quad * 8;
        f32x4 acc = {0.f, 0.f, 0.f, 0.f};
#pragma unroll
        for (int s0 = 0; s0 < 16; s0 += 8) {
            bf16x8 hv[8], wv[8];
#pragma unroll
            for (int u = 0; u < 8; ++u) { hv[u] = *(const bf16x8*)(hp + (s0 + u) * 32); wv[u] = *(const bf16x8*)(wp + (s0 + u) * 32); }
#pragma unroll
            for (int u = 0; u < 8; ++u) acc = __builtin_amdgcn_mfma_f32_16x16x32_bf16(wv[u], hv[u], acc, 0, 0, 0);
        }
        __syncthreads();
        part[wid * 64 + lane] = acc;
        __syncthreads();
        if ((wid & 3) == 0) {
            const f32x4 a = part[wid * 64 + lane] + part[(wid + 1) * 64 + lane] + part[(wid + 2) * 64 + lane] + part[(wid + 3) * 64 + lane];
            const int row = task * 16 + fr;
            const float rs = rsqrtf(((const float*)(ws + WS_SSQ1))[row] * (1.0f / D) + EPS);
            if (quad < 2) *(f32x4*)((float*)(ws + WS_FLOG) + (size_t)row * 8 + quad * 4) = a * rs;
        }
    }
}

__device__ __forceinline__ float log_sigmoid(float v) { return fminf(v, 0.f) - log1pf(expf(-fabsf(v))); }
template <int W> __device__ __forceinline__ void pooled_item(const bf16_t* __restrict__ z, bf16_t* __restrict__ pb  , int b, int t0  , int c0) {
    u32x4 r[W + 7];
#pragma unroll
    for (int i = 0; i < W + 7; ++i) { const int t = t0 - (W - 1) + i; r[i] = (t >= 0) ? *(const u32x4*)(z + (size_t)grow_of(b, t) * ZW + c0) : (u32x4){0u, 0u, 0u, 0u}; }
    float a[8] = {0.f, 0.f, 0.f, 0.f, 0.f, 0.f, 0.f, 0.f};
#pragma unroll
    for (int i = 0; i < W - 1; ++i)
#pragma unroll
        for (int e = 0; e < 4; ++e) { a[2 * e] += bf_lo(r[i][e]); a[2 * e + 1] += bf_hi(r[i][e]); }
#pragma unroll
    for (int i = 0; i < 8; ++i) {
        const u32x4 cur = r[W - 1 + i];
#pragma unroll
        for (int e = 0; e < 4; ++e) { a[2 * e] += bf_lo(cur[e]); a[2 * e + 1] += bf_hi(cur[e]); }
        const int t = t0 + i, cnt = (t + 1 < W) ? t + 1 : W;
        const float inv = 1.0f / (float)cnt;
        u32x4 o;
#pragma unroll
        for (int e = 0; e < 4; ++e) o[e] = cvt_pk_bf16(a[2 * e] * inv - bf_lo(cur[e]), a[2 * e + 1] * inv - bf_hi(cur[e]));
        *(u32x4*)(pb + (size_t)(t - NMETA) * 1024 + c0) = o;
#pragma unroll
        for (int e = 0; e < 4; ++e) { a[2 * e] -= bf_lo(r[i][e]); a[2 * e + 1] -= bf_hi(r[i][e]); }
    }
}
__device__ __forceinline__ void mid_phase(const Params& p, unsigned char* shm, const int wave_s) {
    unsigned char* ws = p.ws;
    int tid_ = phase_tid(wave_s);
    const int tid = tid_, lane = tid & 63, wid = tid >> 6;
    const bf16_t* z = (const bf16_t*)(ws + WS_Z);
    if (blockIdx.x < 32) {
        const int bh = blockIdx.x, b = bh >> 3, h = bh & 7;
        const float* flog = (const float*)(ws + WS_FLOG); float* cum = (float*)(ws + WS_CUM);
        float* wtot = (float*)shm;
        const float bf = p.in[8][h];
        const int t0 = tid * 5;
        float lf[5]; float tot = 0.f;
#pragma unroll
        for (int i = 0; i < 5; ++i) { const int t = t0 + i; lf[i] = (t < L) ? log_sigmoid(flog[(size_t)grow_of(b, t) * 8 + h] + bf) : 0.f; tot += lf[i]; }
        float inc = tot;
#pragma unroll
        for (int o = 1; o < 64; o <<= 1) { const float y = __shfl_up(inc, o); if (lane >= o) inc += y; }
        if (lane == 63) wtot[wid] = inc;
        __syncthreads();
        float run = inc - tot;
        for (int w = 0; w < wid; ++w) run += wtot[w];
#pragma unroll
        for (int i = 0; i < 5; ++i) { const int t = t0 + i; run += lf[i]; if (t < L) cum[bh * CUML + t] = run; }
    }
    if (blockIdx.x < 32) {
        __syncthreads();
        if (tid == 0) { __builtin_amdgcn_fence(__ATOMIC_RELEASE, "agent"); asm volatile("s_waitcnt vmcnt(0)" ::: "memory");
            __hip_atomic_fetch_add((int*)(ws + WS_CTR) + 7, 1, __ATOMIC_RELAXED, __HIP_MEMORY_SCOPE_AGENT); }
    }
}
__device__ __forceinline__ void pooled_for_unit(const Params& p, const int upm, const int upn, const int wave_s) {
    unsigned char* ws = p.ws;
    const int tid = phase_tid(wave_s);
    const bf16_t* z = (const bf16_t*)(ws + WS_Z); bf16_t* pooled = (bf16_t*)(ws + WS_POOLED);
    const int b = upm >> 3, g = upn;
    bf16_t* pb = pooled + (size_t)b * SEQ * 1024;
#pragma unroll
    for (int i = 0; i < 2; ++i) { const int idx = tid + i * 512, rc = idx >> 5, cc = idx & 31;
        const int t0 = NMETA + (upm & 7) * 256 + rc * 8, c0 = g * 256 + cc * 8;
        if (g == 0) pooled_item<2>(z, pb, b, t0, c0); else if (g == 1) pooled_item<4>(z, pb, b, t0, c0); else if (g == 2) pooled_item<8>(z, pb, b, t0, c0); else pooled_item<16>(z, pb, b, t0, c0); }
}

constexpr int V_LDB = 288  ;
constexpr int KS_LD = 144  , VT_LD = 72, AT_VT = 64 * KS_LD * 2, AT_KSC = AT_VT + 128 * VT_LD * 2, AT_KCM = AT_KSC + 256, AT_BUF = AT_KCM + 256  , AT_ITEM = 2 * AT_BUF;
constexpr int N_ITEMS = 32 * 16;
__device__ __forceinline__ void attn_phase(const Params& p, unsigned char* shm, int ctr_idx, const int wave_s) {
    unsigned char* ws = p.ws;
    int tid_ = phase_tid(wave_s);
    const int tid = tid_, wid = tid >> 6, lane = tid & 63, fr = lane & 15, quad = lane >> 4;
    int* itemp = (int*)(shm + AT_ITEM);
    const bf16_t* z = (const bf16_t*)(ws + WS_Z); const float* ssqqk = (const float*)(ws + WS_SSQQK); const float* cum = (const float*)(ws + WS_CUM);
    bf16_t* mix = (bf16_t*)(ws + WS_MIX); int* ctr = (int*)(ws + WS_CTR) + ctr_idx;
    const float* gq = p.in[9]; const float* gkn = p.in[10];
    const float LOG2E = 1.4426950408889634f;
    for (;;) {
        __syncthreads();
        if (tid == 0) *itemp = atomicAdd(ctr, 1);
        __syncthreads();
        const int item = *itemp;
        if (item >= N_ITEMS) break;
        const int j = 16 - item / 32, bh = item & 31, b = bh >> 3, h = bh & 7;
        const int rowbase = 16 + 128 * (j - 1), ntiles = 2 * j + 1;
        const bool wvalid = true;
        const int qr0 = rowbase + 16 * wid;
        const int qrow = qr0 + fr; const size_t grow = (size_t)b * SEQ + (qrow - NMETA);
        const f32x4 qss = *(const f32x4*)(ssqqk + grow * 64 + h * 4);
        const float qs = rsqrtf((qss[0] + qss[1] + qss[2] + qss[3]) * (1.0f / DHD) + EPS) * 0.08838834764831845f;
        bf16x8 qf[4]; float gmax = 0.f;
#pragma unroll
        for (int ks = 0; ks < 4; ++ks) { const int d0 = ks * 32 + quad * 8;
            const u32x4 raw = __builtin_nontemporal_load((const u32x4*)(z + grow * ZW + 1024 + h * DHD + d0));
            const f32x4 a0 = *(const f32x4*)(gq + d0), a1 = *(const f32x4*)(gq + d0 + 4), b0 = *(const f32x4*)(gkn + d0), b1 = *(const f32x4*)(gkn + d0 + 4);
            u32x4 o;
            o[0] = cvt_pk_bf16(bf_lo(raw[0]) * a0[0] * b0[0] * qs, bf_hi(raw[0]) * a0[1] * b0[1] * qs); o[1] = cvt_pk_bf16(bf_lo(raw[1]) * a0[2] * b0[2] * qs, bf_hi(raw[1]) * a0[3] * b0[3] * qs);
            o[2] = cvt_pk_bf16(bf_lo(raw[2]) * a1[0] * b1[0] * qs, bf_hi(raw[2]) * a1[1] * b1[1] * qs); o[3] = cvt_pk_bf16(bf_lo(raw[3]) * a1[2] * b1[2] * qs, bf_hi(raw[3]) * a1[3] * b1[3] * qs);
#pragma unroll
            for (int e = 0; e < 4; ++e) gmax = fmaxf(gmax, fmaxf(fabsf(a0[e] * b0[e]), fabsf(a1[e] * b1[e])));
            qf[ks] = __builtin_bit_cast(bf16x8, o); }
        gmax = fmaxf(gmax, __shfl_xor(gmax, 16)); gmax = fmaxf(gmax, __shfl_xor(gmax, 32));
        const float Coff = gmax * (128.0f * 0.08838834764831845f);
        const float cumq = (cum[bh * CUML + qrow] - Coff) * LOG2E;
        const int vlane = (8 * quad + (fr >> 2)) * V_LDB + ((fr & 3) >> 1) * 16 + 8 * (fr & 1);
        f32x4 O[8];
#pragma unroll
        for (int i = 0; i < 8; ++i) O[i] = (f32x4){0.f, 0.f, 0.f, 0.f};
        float lsum = 0.f;
        u32x4 kreg0[2], vreg0[2], kreg1[2], vreg1[2]; f32x4 kss_r0 = {0.f, 0.f, 0.f, 0.f}, kss_r1 = {0.f, 0.f, 0.f, 0.f}; float kcm_r0 = 0.f, kcm_r1 = 0.f;
#define AT_PREFETCH(kt, R) do { _Pragma("unroll") for (int _i = 0; _i < 2; ++_i) { const int idx = tid + _i * 512, key = idx >> 4, ch = idx & 15; int gkey = (kt) * 64 + key; gkey = gkey < L ? gkey : L - 1; \
            const bf16_t* rp = z + (size_t)grow_of(b, gkey) * ZW + h * DHD + ch * 8; kreg##R[_i] = *(const u32x4*)(rp + 2048); vreg##R[_i] = *(const u32x4*)(rp + 3072); } \
            if (tid < 64) { int gkey = (kt) * 64 + tid; gkey = gkey < L ? gkey : L - 1; kss_r##R = *(const f32x4*)(ssqqk + (size_t)grow_of(b, gkey) * 64 + (8 + h) * 4); kcm_r##R = cum[bh * CUML + gkey]; } } while (0)
#define AT_WRITE(bufp, R) do { bf16_t* Ks_ = (bf16_t*)(bufp); unsigned char* Vb_ = (bufp) + AT_VT; \
            _Pragma("unroll") for (int i = 0; i < 2; ++i) { const int idx = tid + i * 512, key = idx >> 4, ch = idx & 15; \
                const int rho = (key & 32) + ((key >> 2) & 1) * 16 + ((key & 31) >> 3) * 4 + (key & 3); \
                *(u32x4*)(Ks_ + rho * KS_LD + ch * 8) = kreg##R[i]; \
                *(u32x4*)(Vb_ + key * V_LDB + ((ch ^ (((key >> 3) & 1) << 3)) << 4)) = vreg##R[i]; } \
            if (tid < 64) { ((float*)((bufp) + AT_KSC))[tid] = rsqrtf((kss_r##R[0] + kss_r##R[1] + kss_r##R[2] + kss_r##R[3]) * (1.0f / DHD) + EPS) * LOG2E; ((float*)((bufp) + AT_KCM))[tid] = kcm_r##R * LOG2E; } } while (0)
        auto tile_compute = [&](const int kt) __attribute__((always_inline)) {
            unsigned char* bufc = shm + (kt & 1) * AT_BUF;
            const bf16_t* Ks = (const bf16_t*)bufc;
            LAS unsigned char* vA = (LAS unsigned char*)(bufc + AT_VT) + vlane + (quad & 1) * 128; LAS unsigned char* vB = (LAS unsigned char*)(bufc + AT_VT) + vlane - (quad & 1) * 128;
            const float* kscl = (const float*)(bufc + AT_KSC); const float* kcm = (const float*)(bufc + AT_KCM);
            if (kt * 64 <= qr0 + 15) {
                f32x4 S[4];
#pragma unroll
                for (int blk = 0; blk < 4; ++blk) { S[blk] = (f32x4){0.f, 0.f, 0.f, 0.f};
#pragma unroll
                    for (int ks = 0; ks < 4; ++ks) { const bf16x8 kf = *(const bf16x8*)(Ks + (blk * 16 + fr) * KS_LD + ks * 32 + quad * 8);
                        S[blk] = __builtin_amdgcn_mfma_f32_16x16x32_bf16(kf, qf[ks], S[blk], 0, 0, 0); } }
                const bool need_mask = (kt * 64 + 63 > qr0);
                const f32x4 cq4 = {cumq, cumq, cumq, cumq};
#pragma unroll
                for (int blk = 0; blk < 4; ++blk) { const int kb = (blk >> 1) * 32 + quad * 8 + (blk & 1) * 4;
                    const f32x4 sc = *(const f32x4*)(kscl + kb), cm = *(const f32x4*)(kcm + kb);
                    S[blk] = S[blk] * sc + (cq4 - cm); }
                if (need_mask) {
#pragma unroll
                    for (int blk = 0; blk < 4; ++blk) { const int kb = (blk >> 1) * 32 + quad * 8 + (blk & 1) * 4;
#pragma unroll
                        for (int i = 0; i < 4; ++i) if (kt * 64 + kb + i > qrow) S[blk][i] = -1e30f; } }
#pragma unroll
                for (int blk = 0; blk < 4; ++blk)
#pragma unroll
                    for (int i = 0; i < 4; ++i) S[blk][i] = __builtin_amdgcn_exp2f(S[blk][i]);
                { const f32x4 s4 = (S[0] + S[1]) + (S[2] + S[3]); lsum += (s4[0] + s4[1]) + (s4[2] + s4[3]); }
                bf16x8 pf[2];
#pragma unroll
                for (int G = 0; G < 2; ++G) { u32x4 o; o[0] = cvt_pk_bf16(S[2 * G][0], S[2 * G][1]); o[1] = cvt_pk_bf16(S[2 * G][2], S[2 * G][3]);
                    o[2] = cvt_pk_bf16(S[2 * G + 1][0], S[2 * G + 1][1]); o[3] = cvt_pk_bf16(S[2 * G + 1][2], S[2 * G + 1][3]); pf[G] = __builtin_bit_cast(bf16x8, o); }
#pragma unroll
                for (int db = 0; db < 8; ++db)
#pragma unroll
                    for (int G = 0; G < 2; ++G) { LAS unsigned char* vp = (db < 4 ? vA : vB) + (32 * G) * V_LDB + 32 * db;
                        const s16x4 v0 = __builtin_amdgcn_ds_read_tr16_b64_v4i16((LAS s16x4*)vp), v1 = __builtin_amdgcn_ds_read_tr16_b64_v4i16((LAS s16x4*)(vp + 4 * V_LDB));
                        const bf16x8 vf = {v0[0], v0[1], v0[2], v0[3], v1[0], v1[1], v1[2], v1[3]};
                        O[db] = __builtin_amdgcn_mfma_f32_16x16x32_bf16(vf, pf[G], O[db], 0, 0, 0); }
            }
        };
        AT_PREFETCH(0, 0);
        AT_WRITE(shm, 0);
        AT_PREFETCH(1, 1);
        AT_PREFETCH(2, 0);
        LDS_BARRIER();
        for (int kt = 0; kt < ntiles; kt += 2) {
            if (kt + 1 < ntiles) AT_WRITE(shm + AT_BUF, 1);
            if (kt + 3 < ntiles) AT_PREFETCH(kt + 3, 1);
            tile_compute(kt);
            LDS_BARRIER();
            if (kt + 1 < ntiles) {
                if (kt + 2 < ntiles) AT_WRITE(shm, 0);
                if (kt + 4 < ntiles) AT_PREFETCH(kt + 4, 0);
                tile_compute(kt + 1);
                LDS_BARRIER();
            }
        }
#undef AT_PREFETCH
#undef AT_WRITE
        lsum = xsum16_32(lsum);
        const float inv = 1.0f / lsum;
        if (wvalid) {
#pragma unroll
            for (int db = 0; db < 8; ++db) { u32x2 o; o[0] = cvt_pk_bf16(O[db][0] * inv, O[db][1] * inv); o[1] = cvt_pk_bf16(O[db][2] * inv, O[db][3] * inv);
                *(u32x2*)(mix + grow * D + 1024 + h * DHD + db * 16 + quad * 4) = o; }
        }
    }
}

constexpr int LDS_BYTES = STAGE_BYTES + 16;
__global__ __launch_bounds__(512, 2) void hymba_fwd(Params p) {
    extern __shared__ __attribute__((aligned(16))) unsigned char shm[];
    LAS unsigned char* lds = (LAS unsigned char*)shm;
    cg::grid_group grid = cg::this_grid();
    unsigned char* ws = p.ws;
    bf16_t* hb = (bf16_t*)(ws + WS_HB); bf16_t* act = (bf16_t*)(ws + WS_ACT); bf16_t* z = (bf16_t*)(ws + WS_Z); bf16_t* mix = (bf16_t*)(ws + WS_MIX);
    float* hmeta = (float*)(ws + WS_HMETA);
    float* ssq0 = (float*)(ws + WS_SSQ0); float* ssq1 = (float*)(ws + WS_SSQ1); float* ssq2 = (float*)(ws + WS_SSQ2);
    const int G = gridDim.x, c = blockIdx.x;
    const int wave_s = __builtin_amdgcn_readfirstlane((int)threadIdx.x >> 6);
    StaticOrder S;
    if (phase_tid(wave_s) == 0) { *(volatile LAS unsigned*)(lds + STAGE_BYTES) = 0u; *(volatile LAS unsigned*)(lds + STAGE_BYTES + 4) = 0u; }
    __syncthreads();
    const XcdBarrier xb = xcd_barrier_post((unsigned*)(ws + WS_BAR), (volatile LAS unsigned*)(lds + STAGE_BYTES), wave_s);

    prep_phase(p, shm, wave_s);
    if (p.ws == nullptr) grid.sync();
    xcd_barrier(xb, wave_s);
    { Gemm g{hb, (const bf16_t*)(ws + WS_GU1), D, D, D, 0}; S.init(32, 44, G, c); EpiSwiGLU E{ssq0, act}; gemm_phase(lds, g, S, E, wave_s);
    }
    skinny_phase<1, 8, 8>(p, shm, 1, 352, wave_s);
    cvt_queue<0>(p, shm, 4, 800 + 1408, wave_s);
    xcd_barrier(xb, wave_s);
    { Gemm g{act, (const bf16_t*)(ws + WS_D1), DFF, DFF, DFF, 0}; S.init(32, 8, G, c); EpiRes<2> E{p.in[0], p.in[1], p.out, hmeta, hb, ssq1}; gemm_phase(lds, g, S, E, wave_s); }
    skinny_phase<2, 22, 11>(p, shm, 2, 128, wave_s);
    xcd_barrier(xb, wave_s);
    { Gemm g{hb, (const bf16_t*)(ws + WS_IN), D, D, D, 0}; S.init(32, 16, G, c); EpiZ E{ssq1, z, (float*)(ws + WS_FLOG), (float*)(ws + WS_SSQQK)}; gemm_phase(lds, g, S, E, wave_s); }
    skinny_phase<3, 8, 8>(p, shm, 3, 257, wave_s);
    flog_phase(p, shm, wave_s);
    xcd_barrier(xb, wave_s);
    mid_phase(p, shm, wave_s);
    { Gemm g{(const bf16_t*)(ws + WS_POOLED), (const bf16_t*)(ws + WS_POOL), 1024, 256, 256, 512}; S.init(32, 4, G, c); EpiPlain E{mix};
      for (int i = 0;; ++i) { Unit u; if (!S.next(i, u)) break; pooled_for_unit(p, u.pm, u.pn, wave_s); }
      asm volatile("s_waitcnt vmcnt(0)" ::: "memory"); __syncthreads();
      gemm_phase(lds, g, S, E, wave_s); }
    { if (phase_tid(wave_s) == 0) { int* flag = (int*)(ws + WS_CTR) + 7; unsigned sp = 0;
          while (__hip_atomic_load(flag, __ATOMIC_RELAXED, __HIP_MEMORY_SCOPE_AGENT) < 32) { __builtin_amdgcn_s_sleep(1); if (++sp > (1u << 22)) break; }
          __builtin_amdgcn_fence(__ATOMIC_ACQUIRE, "agent"); asm volatile("s_waitcnt vmcnt(0)" ::: "memory"); }
      __syncthreads(); }
    attn_phase(p, shm, 0, wave_s);
    xcd_barrier(xb, wave_s);
    { Gemm g{mix, (const bf16_t*)(ws + WS_OUT), D, D, D, 0}; S.init(32, 8, G, c); EpiRes<6> E{p.in[0], p.in[1], p.out, hmeta, hb, ssq2}; gemm_phase(lds, g, S, E, wave_s); }
    xcd_barrier(xb, wave_s);
    { Gemm g{hb, (const bf16_t*)(ws + WS_GU2), D, D, D, 0}; S.init(32, 44, G, c); EpiSwiGLU E{ssq2, act}; gemm_phase(lds, g, S, E, wave_s); }
    cvt_queue<1>(p, shm, 5, 704, wave_s);
    xcd_barrier(xb, wave_s);
    { Gemm g{act, (const bf16_t*)(ws + WS_D2), DFF, DFF, DFF, 0}; S.init(32, 8, G, c); EpiRes<8> E{p.in[0], p.in[1], p.out, hmeta, hb, ssq2}; gemm_phase(lds, g, S, E, wave_s); }
}

extern "C" void kernel_launch(void* const* d_in, const int* in_sizes, int n_in, void* d_out, int out_size, void* d_ws, size_t ws_size, hipStream_t stream) {
    static int grid_blocks = 0;
    if (grid_blocks == 0) {
        if (n_in != 18 || ws_size < WS_END) { fprintf(stderr, "kernel_launch: need 18 inputs and %zu bytes of workspace (got %d, %zu)\n", (size_t)WS_END, n_in, ws_size); grid_blocks = -1; return; }
        int dev = 0, cus = 0, per_cu = 0;
        (void)hipGetDevice(&dev);
        (void)hipDeviceGetAttribute(&cus, hipDeviceAttributeMultiprocessorCount, dev);
        (void)hipFuncSetAttribute((const void*)hymba_fwd, hipFuncAttributeMaxDynamicSharedMemorySize, LDS_BYTES);
        (void)hipOccupancyMaxActiveBlocksPerMultiprocessor(&per_cu, (const void*)hymba_fwd, 512, LDS_BYTES);
        if (per_cu < 1) per_cu = 1;
        grid_blocks = cus * per_cu;
    }
    if (grid_blocks < 0) return;
    if (hipMemsetAsync((char*)d_ws + WS_BAR, 0, XCD_BAR_WORDS * 4, stream) != hipSuccess) { fprintf(stderr, "memset failed\n"); return; }
    Params p{};
    for (int i = 0; i < 18; ++i) p.in[i] = (const float*)d_in[i];
    p.out = (float*)d_out; p.ws = (unsigned char*)d_ws;
    void* args[] = {&p};
    hipError_t e = hipLaunchCooperativeKernel((const void*)hymba_fwd, dim3(grid_blocks), dim3(512), args, LDS_BYTES, stream);
    if (e != hipSuccess) fprintf(stderr, "cooperative launch failed: %s (grid %d)\n", hipGetErrorString(e), grid_blocks);
}
```
